# Optimizing an MI355X kernel written in HIP

```python
import math
import jax, jax.numpy as jnp
from jax import lax
import numpy as np

D_MODEL = 1024
BATCH = 1
SEQ = 16384
DEPTH = 1

PLE_DIM = 256
D_FF = 2816
EPS = 1e-6
MLA_HEADS = 8
MLA_Q_RANK = 256
MLA_KV_RANK = 256
MLA_NOPE = 64
MLA_ROPE = 32
MLA_V = 64
ROPE_THETA = 10000.0
Q_BLOCK = 128
ML_HEADS = 4
ML_QK = 64
ML_V = 128
ML_CHUNK = 128
CONV_W = 5
N_DIR = 2
MLA_OUT = MLA_HEADS * MLA_V
ML_OUT = ML_HEADS * ML_V
IN_SPLITS = (MLA_Q_RANK, MLA_KV_RANK, MLA_ROPE, ML_HEADS * ML_QK, ML_HEADS * ML_QK, ML_OUT,
             N_DIR * ML_HEADS, N_DIR * ML_HEADS, ML_OUT, 2 * D_MODEL)
IN_WIDTH = sum(IN_SPLITS)

kernel_name = 'hybrid_mla_mlstm_macaron_encoder'


def rmsnorm(x, w):
    xf = x.astype(jnp.float32)
    y = xf * lax.rsqrt(jnp.mean(xf * xf, axis=-1, keepdims=True) + EPS)
    return (y * w.astype(jnp.float32)).astype(x.dtype)


def swiglu(x, w_gate, w_up, w_down):
    return (jax.nn.silu(x @ w_gate) * (x @ w_up)) @ w_down


def apply_rope(x, cos, sin):
    half = x.shape[-1] // 2
    x1, x2 = x[..., :half], x[..., half:]
    return jnp.concatenate([x1 * cos - x2 * sin, x2 * cos + x1 * sin], axis=-1)


def depthwise_conv(x, w, b):
    C = x.shape[-1]
    y = lax.conv_general_dilated(x, w[:, None, :].astype(x.dtype), window_strides=(1,),
                                 padding=[(CONV_W // 2, CONV_W // 2)],
                                 dimension_numbers=('NWC', 'WIO', 'NWC'),
                                 feature_group_count=C)
    return y + b


def mla_branch(c_q, c_kv, k_r, cos, sin, q_norm, kv_norm, w_uq, w_uk, w_uv):
    B, S, _ = c_q.shape
    q = (rmsnorm(c_q, q_norm) @ w_uq).reshape(B, S, MLA_HEADS, MLA_NOPE + MLA_ROPE)
    q_nope = q[..., :MLA_NOPE]
    q_rope = apply_rope(q[..., MLA_NOPE:], cos[:, :, None, :], sin[:, :, None, :])
    ckv = rmsnorm(c_kv, kv_norm)
    k_nope = (ckv @ w_uk).reshape(B, S, MLA_HEADS, MLA_NOPE)
    v = (ckv @ w_uv).reshape(B, S, MLA_HEADS, MLA_V)
    k_rope = apply_rope(k_r, cos, sin)
    scale = (MLA_NOPE + MLA_ROPE) ** -0.5
    nb = S // Q_BLOCK
    qn_b = q_nope.reshape(B, nb, Q_BLOCK, MLA_HEADS, MLA_NOPE).transpose(1, 0, 2, 3, 4)
    qr_b = q_rope.reshape(B, nb, Q_BLOCK, MLA_HEADS, MLA_ROPE).transpose(1, 0, 2, 3, 4)

    def block(args):
        qn, qr = args
        s = (jnp.einsum('bqhd,bkhd->bhqk', qn, k_nope)
             + jnp.einsum('bqhd,bkd->bhqk', qr, k_rope))
        pr = jax.nn.softmax(s.astype(jnp.float32) * scale, axis=-1).astype(v.dtype)
        return jnp.einsum('bhqk,bkhd->bqhd', pr, v)

    o = lax.map(block, (qn_b, qr_b))
    return o.transpose(1, 0, 2, 3, 4).reshape(B, S, MLA_OUT)


def mlstm_chunkwise(q, k, v, li, lf):
    dtype = v.dtype
    q, k, v, li, lf = (t.astype(jnp.float32) for t in (q, k, v, li, lf))
    N, H, S, dk = q.shape
    dv = v.shape[-1]
    L = ML_CHUNK
    nc = S // L
    qc = q.reshape(N, H, nc, L, dk).transpose(2, 0, 1, 3, 4)
    kc = k.reshape(N, H, nc, L, dk).transpose(2, 0, 1, 3, 4)
    vc = v.reshape(N, H, nc, L, dv).transpose(2, 0, 1, 3, 4)
    ic = li.reshape(N, H, nc, L).transpose(2, 0, 1, 3)
    fc = lf.reshape(N, H, nc, L).transpose(2, 0, 1, 3)
    mask = jnp.tril(jnp.ones((L, L), dtype=bool))

    def step(carry, inp):
        C, n, m = carry
        qb, kb, vb, ib, fb = inp
        b = jnp.cumsum(fb, axis=-1)
        dmat = jnp.where(mask, b[..., :, None] - b[..., None, :] + ib[..., None, :], -jnp.inf)
        m_t = jnp.maximum(b + m[..., None], jnp.max(dmat, axis=-1))
        inter = jnp.exp(b + m[..., None] - m_t)
        s = jnp.einsum('nhtd,nhsd->nhts', qb, kb) * jnp.exp(dmat - m_t[..., None])
        num = (jnp.einsum('nhts,nhsv->nhtv', s, vb)
               + inter[..., None] * jnp.einsum('nhtd,nhdv->nhtv', qb, C))
        den = jnp.sum(s, axis=-1) + inter * jnp.einsum('nhtd,nhd->nht', qb, n)
        h = num / jnp.maximum(jnp.abs(den), jnp.exp(-m_t))[..., None]
        b_end = b[..., -1]
        g = b_end[..., None] - b + ib
        m_new = jnp.maximum(b_end + m, jnp.max(g, axis=-1))
        decay = jnp.exp(b_end + m - m_new)
        wgt = jnp.exp(g - m_new[..., None])
        C_new = decay[..., None, None] * C + jnp.einsum('nhs,nhsd,nhsv->nhdv', wgt, kb, vb)
        n_new = decay[..., None] * n + jnp.einsum('nhs,nhsd->nhd', wgt, kb)
        return (C_new, n_new, m_new), h

    init = (jnp.zeros((N, H, dk, dv), jnp.float32), jnp.zeros((N, H, dk), jnp.float32),
            jnp.zeros((N, H), jnp.float32))
    _, hs = lax.scan(step, init, (qc, kc, vc, ic, fc))
    return hs.transpose(1, 2, 0, 3, 4).reshape(N, H, S, dv).astype(dtype)


def mlstm_branch(ml_q, ml_k, ml_v, ml_i, ml_f, ml_o, conv_w, conv_b, i_bias, f_bias, head_norm):
    B, S, _ = ml_q.shape
    qk = jax.nn.silu(depthwise_conv(jnp.concatenate([ml_q, ml_k], axis=-1), conv_w, conv_b))
    q, k = jnp.split(qk, 2, axis=-1)
    q = q.reshape(B, S, ML_HEADS, ML_QK).transpose(0, 2, 1, 3)
    k = k.reshape(B, S, ML_HEADS, ML_QK).transpose(0, 2, 1, 3) * (ML_QK ** -0.5)
    v = ml_v.reshape(B, S, ML_HEADS, ML_V).transpose(0, 2, 1, 3)
    li = (ml_i.reshape(B, S, N_DIR, ML_HEADS) + i_bias).transpose(2, 0, 3, 1)
    lf = jax.nn.log_sigmoid(ml_f.reshape(B, S, N_DIR, ML_HEADS) + f_bias).transpose(2, 0, 3, 1)
    qd = jnp.stack([q, q[:, :, ::-1]]).reshape(N_DIR * B, ML_HEADS, S, ML_QK)
    kd = jnp.stack([k, k[:, :, ::-1]]).reshape(N_DIR * B, ML_HEADS, S, ML_QK)
    vd = jnp.stack([v, v[:, :, ::-1]]).reshape(N_DIR * B, ML_HEADS, S, ML_V)
    lid = jnp.stack([li[0], li[1][..., ::-1]]).reshape(N_DIR * B, ML_HEADS, S)
    lfd = jnp.stack([lf[0], lf[1][..., ::-1]]).reshape(N_DIR * B, ML_HEADS, S)
    hs = mlstm_chunkwise(qd, kd, vd, lid, lfd).reshape(N_DIR, B, ML_HEADS, S, ML_V)
    h = (hs[0] + hs[1][:, :, ::-1]).transpose(0, 2, 1, 3)
    h = rmsnorm(h, head_norm.reshape(ML_HEADS, ML_V)).reshape(B, S, ML_OUT)
    return h * jax.nn.sigmoid(ml_o)


def setup_inputs(seed: int = 0) -> dict:
    key = jax.random.key(seed)
    k = jax.random.split(key, 40)

    def w(kk, shape, fan_in):
        return jax.random.normal(kk, (DEPTH,) + shape, jnp.float32) * (fan_in ** -0.5)

    def gain(kk, n):
        return 1.0 + 0.05 * jax.random.normal(kk, (DEPTH, n), jnp.float32)

    x = jax.random.normal(k[0], (BATCH, SEQ, D_MODEL), jnp.float32)
    p = jax.random.normal(k[1], (DEPTH, BATCH, SEQ, PLE_DIM), jnp.float32)
    positions = (jnp.arange(SEQ, dtype=jnp.int32)[None, :]
                 + jax.random.randint(k[2], (BATCH, 1), 0, 1024, dtype=jnp.int32))
    return {
        'x': x, 'p': p, 'positions': positions,
        'ffn1_pre_norm': gain(k[3], D_MODEL), 'ffn1_post_norm': gain(k[4], D_MODEL),
        'ffn1_w_gate': w(k[5], (D_MODEL, D_FF), D_MODEL), 'ffn1_w_up': w(k[6], (D_MODEL, D_FF), D_MODEL),
        'ffn1_w_down': w(k[7], (D_FF, D_MODEL), D_FF),
        'mix_pre_norm': gain(k[8], D_MODEL), 'mix_post_norm': gain(k[9], D_MODEL),
        'w_in': w(k[10], (D_MODEL, IN_WIDTH), D_MODEL),
        'mla_q_norm': gain(k[11], MLA_Q_RANK), 'mla_kv_norm': gain(k[12], MLA_KV_RANK),
        'mla_w_uq': w(k[13], (MLA_Q_RANK, MLA_HEADS * (MLA_NOPE + MLA_ROPE)), MLA_Q_RANK),
        'mla_w_uk': w(k[14], (MLA_KV_RANK, MLA_HEADS * MLA_NOPE), MLA_KV_RANK),
        'mla_w_uv': w(k[15], (MLA_KV_RANK, MLA_HEADS * MLA_V), MLA_KV_RANK),
        'ml_conv_w': w(k[16], (CONV_W, 2 * ML_HEADS * ML_QK), CONV_W),
        'ml_conv_b': 0.02 * jax.random.normal(k[17], (DEPTH, 2 * ML_HEADS * ML_QK), jnp.float32),
        'ml_i_bias': -1.0 + 0.1 * jax.random.normal(k[18], (DEPTH, N_DIR, ML_HEADS), jnp.float32),
        'ml_f_bias': 3.0 + 0.5 * jax.random.normal(k[19], (DEPTH, N_DIR, ML_HEADS), jnp.float32),
        'ml_head_norm': gain(k[20], ML_OUT),
        'w_branch_mla': w(k[21], (MLA_OUT, D_MODEL), MLA_OUT),
        'w_branch_ml': w(k[22], (ML_OUT, D_MODEL), ML_OUT),
        'w_out': w(k[23], (D_MODEL, D_MODEL), D_MODEL),
        'ffn2_pre_norm': gain(k[24], D_MODEL), 'ffn2_post_norm': gain(k[25], D_MODEL),
        'ffn2_w_gate': w(k[26], (D_MODEL, D_FF), D_MODEL), 'ffn2_w_up': w(k[27], (D_MODEL, D_FF), D_MODEL),
        'ffn2_w_down': w(k[28], (D_FF, D_MODEL), D_FF),
        'ple_pre_norm': gain(k[29], D_MODEL), 'ple_post_norm': gain(k[30], D_MODEL),
        'ple_w_proj': w(k[31], (PLE_DIM, D_MODEL), PLE_DIM),
        'ple_w_gate': w(k[32], (D_MODEL, D_MODEL), D_MODEL),
    }


def reference(x, p, positions,
              ffn1_pre_norm, ffn1_post_norm, ffn1_w_gate, ffn1_w_up, ffn1_w_down,
              mix_pre_norm, mix_post_norm, w_in,
              mla_q_norm, mla_kv_norm, mla_w_uq, mla_w_uk, mla_w_uv,
              ml_conv_w, ml_conv_b, ml_i_bias, ml_f_bias, ml_head_norm,
              w_branch_mla, w_branch_ml, w_out,
              ffn2_pre_norm, ffn2_post_norm, ffn2_w_gate, ffn2_w_up, ffn2_w_down,
              ple_pre_norm, ple_post_norm, ple_w_proj, ple_w_gate):
    inv_freq = ROPE_THETA ** (-jnp.arange(0, MLA_ROPE, 2, dtype=jnp.float32) / MLA_ROPE)
    ang = positions.astype(jnp.float32)[..., None] * inv_freq
    cos = jnp.cos(ang).astype(x.dtype)
    sin = jnp.sin(ang).astype(x.dtype)
    split_idx = [int(s) for s in np.cumsum(IN_SPLITS)[:-1]]

    h = x
    for i in range(DEPTH):
        u = rmsnorm(h, ffn1_pre_norm[i])
        h = h + 0.5 * rmsnorm(swiglu(u, ffn1_w_gate[i], ffn1_w_up[i], ffn1_w_down[i]), ffn1_post_norm[i])

        u = rmsnorm(h, mix_pre_norm[i])
        z = u @ w_in[i]
        c_q, c_kv, k_r, ml_q, ml_k, ml_v, ml_i, ml_f, ml_o, gates = jnp.split(z, split_idx, axis=-1)
        a = mla_branch(c_q, c_kv, k_r, cos, sin, mla_q_norm[i], mla_kv_norm[i],
                       mla_w_uq[i], mla_w_uk[i], mla_w_uv[i]) @ w_branch_mla[i]
        bm = mlstm_branch(ml_q, ml_k, ml_v, ml_i, ml_f, ml_o, ml_conv_w[i], ml_conv_b[i],
                          ml_i_bias[i], ml_f_bias[i], ml_head_norm[i]) @ w_branch_ml[i]
        g_a, g_b = jnp.split(jax.nn.sigmoid(gates), 2, axis=-1)
        mixed = (g_a * a + g_b * bm) @ w_out[i]
        h = h + rmsnorm(mixed, mix_post_norm[i])

        u = rmsnorm(h, ffn2_pre_norm[i])
        h = h + 0.5 * rmsnorm(swiglu(u, ffn2_w_gate[i], ffn2_w_up[i], ffn2_w_down[i]), ffn2_post_norm[i])

        e = p[i] @ ple_w_proj[i]
        g = jax.nn.sigmoid(rmsnorm(h, ple_pre_norm[i]) @ ple_w_gate[i])
        h = h + rmsnorm(g * e, ple_post_norm[i])
    return h
```

```cpp
#include <hip/hip_runtime.h>
#include <hip/hip_bf16.h>
#include <cstdio>
#include <cstdint>

constexpr int S = 16384, DM = 1024, FF = 2816, PLE = 256;
constexpr int NWIN = 4352;
constexpr float EPS = 1e-6f;
constexpr int NTHREADS = 512, NWAVES = 8;

constexpr size_t MiB = 1u << 20;
constexpr size_t WS_CTL = 0, CTL_ZERO_BYTES = 1 * MiB;
constexpr size_t WS_SSQ_Q = 64 * 1024, WS_SSQ_KV = 128 * 1024;
constexpr size_t WS_COS = 1 * MiB, WS_SIN = 2 * MiB;
constexpr size_t WS_LI = 3 * MiB, WS_LF = 3 * MiB + 512 * 1024;
constexpr size_t WS_MLOC = 4 * MiB, WS_TOT = 4 * MiB + 4096, WS_MPREV = 4 * MiB + 8192;
constexpr size_t WS_DN = 4 * MiB + 64 * 1024, WS_NPREV = 4 * MiB + 320 * 1024;
constexpr size_t WS_KR = 5 * MiB;
constexpr size_t W_GU1 = 8 * MiB, W_D1 = 19 * MiB, W_IN = 24 * MiB + 512 * 1024, W_UQKV = 33 * MiB;
constexpr size_t W_PLE = W_UQKV + (size_t)(768 + 1024) * 256 * 2;
constexpr size_t W_A = 35 * MiB, W_B = 36 * MiB, W_OUT = 37 * MiB, W_GU2 = 39 * MiB, W_D2 = 50 * MiB, W_PG = 56 * MiB;
constexpr size_t A_XN = 60 * MiB, A_HID = 92 * MiB, A_Y = 184 * MiB;
constexpr size_t A_GATES = 94 * MiB, A_MLQK = 158 * MiB, A_MLV = 174 * MiB, A_MLO = 190 * MiB, A_CQ = 206 * MiB, A_CKV = 214 * MiB;
constexpr size_t A_DC = 60 * MiB, A_CPREV = 222 * MiB, A_BM = 238 * MiB;
constexpr size_t A_Q = 60 * MiB, A_KN = 158 * MiB, A_V = 174 * MiB, A_O = 190 * MiB, A_MIX = 206 * MiB, A_Y2 = 94 * MiB;
constexpr size_t A_PB = 92 * MiB, A_E = 100 * MiB;
constexpr size_t WS_END = 256 * MiB;

typedef unsigned short bf16_t;
typedef short bf16x8 __attribute__((ext_vector_type(8)));
typedef float f32x4 __attribute__((ext_vector_type(4)));
typedef float f32x2 __attribute__((ext_vector_type(2)));
typedef float f32x16 __attribute__((ext_vector_type(16)));
typedef unsigned u32x4 __attribute__((ext_vector_type(4)));
typedef unsigned u32x2 __attribute__((ext_vector_type(2)));
typedef short s16x4 __attribute__((ext_vector_type(4)));
#define LAS __attribute__((address_space(3)))

__device__ __forceinline__ unsigned cvt_pk_bf16(float lo, float hi) { unsigned r; asm volatile("v_cvt_pk_bf16_f32 %0, %1, %2" : "=v"(r) : "v"(lo), "v"(hi)); return r; }
__device__ __forceinline__ unsigned f2bf(float f) { unsigned u = __builtin_bit_cast(unsigned, f); return (u + 0x7fffu + ((u >> 16) & 1u)) >> 16; }
__device__ __forceinline__ float bflo(unsigned w) { return __builtin_bit_cast(float, w << 16); }
__device__ __forceinline__ float bfhi(unsigned w) { return __builtin_bit_cast(float, w & 0xffff0000u); }
__device__ __forceinline__ float sigmoid_f(float x) { return __builtin_amdgcn_rcpf(1.f + __builtin_amdgcn_exp2f(-1.4426950408889634f * x)); }
__device__ __forceinline__ float silu_f(float x) { return x * sigmoid_f(x); }
__device__ __forceinline__ float wave_sum(float v) {
#pragma unroll
    for (int o = 1; o < 64; o <<= 1) v += __shfl_xor(v, o);
    return v;
}
__device__ __forceinline__ float wave_max(float v) {
#pragma unroll
    for (int o = 1; o < 64; o <<= 1) v = fmaxf(v, __shfl_xor(v, o));
    return v;
}

namespace pg8 {
constexpr int BM = 256, BK = 64, HALF = 128, HTB = HALF * BK * 2, STAGE_BYTES = 8 * HTB, NXCD = 8, WGM = 8;
__host__ __device__ __forceinline__ int lds_byte(int r, int c) { const int st = (r >> 4) * 2 + (c >> 5), rr = r & 15, cc = c & 31, ob = rr * 64 + cc * 2; return st * 1024 + (ob ^ (((ob >> 9) & 1) << 5)); }
__host__ __device__ __forceinline__ void stage_rc(int b, int& R, int& C) { const int st = b / 1024, sb = b % 1024, swz = sb ^ (((sb >> 9) & 1) << 5); R = (st >> 1) * 16 + swz / 64; C = (st & 1) * 32 + (swz % 64) / 2; }
__host__ __device__ __forceinline__ int perm32(int rho) { const int n = rho >> 4, i = rho & 15; return 8 * (i >> 2) + 4 * n + (i & 3); }

struct Unit { int pm, pn, kind; const char* A; const char* B; };

__device__ __forceinline__ void tile_map(int L, int nM, int nN, int& pm, int& pn) {
    const int nwg = nM * nN; int wgid = L;
    { const int q = nwg / NXCD, r = nwg % NXCD, xcd = wgid % NXCD, off = wgid / NXCD; wgid = (xcd < r ? xcd * (q + 1) : r * (q + 1) + (xcd - r) * q) + off; }
    const int nig = WGM * nN, gid = wgid / nig, fm = gid * WGM, gsz = (nM - fm) < WGM ? (nM - fm) : WGM;
    pm = fm + ((wgid % nig) % gsz); pn = (wgid % nig) / gsz;
}
template <int NN, int N0, int N1, size_t OA0, size_t OA1, size_t OA2, size_t OB, int K>
struct SchedGrid {
    int G, c; const char* ws;
    __device__ __forceinline__ bool next(int i, Unit& u) const {
        constexpr size_t tstep = (size_t)256 * K * 2;
        const long L = (long)i * G + c; if (L >= (long)64 * NN) return false;
        tile_map((int)L, 64, NN, u.pm, u.pn); u.kind = 0;
        const size_t oa = (u.pn < N0 ? OA0 : (u.pn < N1 ? OA1 : OA2));
        u.A = ws + oa + (size_t)u.pm * tstep; u.B = ws + OB + (size_t)u.pn * tstep; return true;
    }
};
template <int NN, size_t OA0, size_t OA1, size_t OB0, size_t OB1, int K>
struct SchedPair {
    int G, c; const char* ws;
    __device__ __forceinline__ bool next(int i, Unit& u) const {
        constexpr size_t tstep = (size_t)256 * K * 2;
        const long L = (long)(i >> 1) * G + c; if (L >= (long)64 * NN) return false;
        tile_map((int)L, 64, NN, u.pm, u.pn); u.kind = i & 1;
        u.A = ws + ((i & 1) ? OA1 : OA0) + (size_t)u.pm * tstep; u.B = ws + ((i & 1) ? OB1 : OB0) + (size_t)u.pn * tstep; return true;
    }
};

template <class Epi, class Sched, bool ALIGN_EPI>
__device__ __forceinline__ void gemm_phase(LAS unsigned char* lds, const int K, const Sched& S, const Epi& E) {
    const int tid = threadIdx.x, wid = __builtin_amdgcn_readfirstlane(tid >> 6), lane = tid & 63, wr = wid >> 2, wc = wid & 3, fr = lane & 15, fq = lane >> 4;
    const int nt = K / BK;
    unsigned voffA[2], voffB[2];
#pragma unroll
    for (int i = 0; i < 2; ++i) { int R, C; stage_rc(tid * 16 + i * 8192, R, C); const int Rb = Epi::PERM ? ((R & ~31) + perm32(R & 31)) : R;
        voffA[i] = (unsigned)(R * K + C) * 2u; voffB[i] = (unsigned)(Rb * K + C) * 2u; }
    const size_t kstep = (size_t)(BK * 2);
    const size_t hstep = (size_t)HALF * K * 2;
    const unsigned ldsw = (unsigned)wid * 1024u;
    const int aoff = lds_byte(wr * 64 + fr, fq * 8), boff = lds_byte(wc * 32 + fr, fq * 8);
#define PG8_SA(b, h) (((b) * 2 + (h)) * HTB)
#define PG8_SB(b, h) ((4 + (b) * 2 + (h)) * HTB)
#define PG8_STAGE(bufoff, gbase, voff) do { _Pragma("unroll") for (int _i = 0; _i < 2; ++_i) \
        __builtin_amdgcn_global_load_lds((const unsigned*)((const char*)(gbase) + (voff)[_i]), (LAS unsigned*)(lds + (bufoff) + ldsw + _i * 8192), 16, 0, 0); } while (0)
#define PG8_LDA(dst, b, h) do { _Pragma("unroll") for (int m = 0; m < 4; ++m) _Pragma("unroll") for (int k = 0; k < 2; ++k) dst[m][k] = *(const LAS bf16x8*)(lds + PG8_SA(b, h) + aoff + m * 2048 + k * 1024); } while (0)
#define PG8_LDB(dst, b, h) do { _Pragma("unroll") for (int n = 0; n < 2; ++n) _Pragma("unroll") for (int k = 0; k < 2; ++k) dst[n][k] = *(const LAS bf16x8*)(lds + PG8_SB(b, h) + boff + n * 2048 + k * 1024); } while (0)
#define PG8_MMA(ai, bj, At, Bt) do { __builtin_amdgcn_s_setprio(1); _Pragma("unroll") for (int m = 0; m < 4; ++m) _Pragma("unroll") for (int n = 0; n < 2; ++n) _Pragma("unroll") for (int k = 0; k < 2; ++k) \
        acc[ai][bj][m][n] = __builtin_amdgcn_mfma_f32_16x16x32_bf16(Bt[n][k], At[m][k], acc[ai][bj][m][n], 0, 0, 0); __builtin_amdgcn_s_setprio(0); } while (0)
#define PG8_WAIT_V(n) asm volatile("s_waitcnt vmcnt(" #n ")" ::: "memory")
#define PG8_WAIT_L(n) asm volatile("s_waitcnt lgkmcnt(" #n ")" ::: "memory")
#define PG8_BAR __builtin_amdgcn_s_barrier()
#define PG8_SCHED __builtin_amdgcn_sched_barrier(0)
    Unit cur, nxt; int ui = 0;
    if (!S.next(0, cur)) return;
    f32x4 acc[2][2][4][2];
#pragma unroll
    for (int a = 0; a < 2; ++a)
#pragma unroll
        for (int b = 0; b < 2; ++b)
#pragma unroll
            for (int m = 0; m < 4; ++m)
#pragma unroll
                for (int n = 0; n < 2; ++n) acc[a][b][m][n] = (f32x4){0.f, 0.f, 0.f, 0.f};
    bf16x8 At[4][2], B0[2][2], B1[2][2];
    const char* cA = cur.A; const char* cB = cur.B;
    PG8_STAGE(PG8_SB(0, 0), cB, voffB); PG8_STAGE(PG8_SB(0, 1), cB + hstep, voffB); PG8_STAGE(PG8_SA(0, 0), cA, voffA); PG8_STAGE(PG8_SA(0, 1), cA + hstep, voffA);
    if (wr == 1) PG8_BAR;
    PG8_WAIT_V(2); PG8_BAR;
    PG8_STAGE(PG8_SB(1, 0), cB + kstep, voffB); PG8_STAGE(PG8_SA(1, 0), cA + kstep, voffA); PG8_STAGE(PG8_SB(1, 1), cB + hstep + kstep, voffB);
    PG8_WAIT_V(6); PG8_BAR;
    for (;;) {
        const bool has_next = S.next(ui + 1, nxt);
        const char* nA = has_next ? nxt.A : cA; const char* nB = has_next ? nxt.B : cB;
#pragma unroll 1
        for (int t = 0; t < nt; t += 2) {
            const bool last = (t == nt - 2);
            const char* a1 = cA + (size_t)(t + 1) * kstep;
            const char* a2 = last ? nA : cA + (size_t)(t + 2) * kstep; const char* b2 = last ? nB : cB + (size_t)(t + 2) * kstep;
            const char* a3 = a2 + kstep; const char* b3 = b2 + kstep;
            PG8_LDB(B0, 0, 0); PG8_LDB(B1, 0, 1); PG8_SCHED; PG8_LDA(At, 0, 0); PG8_STAGE(PG8_SA(1, 1), a1 + hstep, voffA);
            PG8_WAIT_V(8); PG8_WAIT_L(0); PG8_BAR; PG8_MMA(0, 0, At, B0); PG8_MMA(0, 1, At, B1); PG8_BAR; PG8_SCHED;
            PG8_LDA(At, 0, 1); PG8_STAGE(PG8_SB(0, 0), b2, voffB); PG8_STAGE(PG8_SB(0, 1), b2 + hstep, voffB); PG8_STAGE(PG8_SA(0, 0), a2, voffA);
            PG8_WAIT_V(8); PG8_WAIT_L(0); PG8_BAR; PG8_MMA(1, 0, At, B0); PG8_MMA(1, 1, At, B1); PG8_BAR; PG8_SCHED;
            PG8_LDB(B0, 1, 0); PG8_LDB(B1, 1, 1); PG8_SCHED; PG8_LDA(At, 1, 0); PG8_STAGE(PG8_SA(0, 1), a2 + hstep, voffA);
            PG8_WAIT_V(8); PG8_WAIT_L(0); PG8_BAR; PG8_MMA(0, 0, At, B0); PG8_MMA(0, 1, At, B1); PG8_BAR; PG8_SCHED;
            PG8_LDA(At, 1, 1); PG8_STAGE(PG8_SB(1, 0), b3, voffB); PG8_STAGE(PG8_SB(1, 1), b3 + hstep, voffB); PG8_STAGE(PG8_SA(1, 0), a3, voffA);
            PG8_WAIT_V(8); PG8_WAIT_L(0); PG8_BAR; PG8_MMA(1, 0, At, B0); PG8_MMA(1, 1, At, B1); PG8_BAR; PG8_SCHED;
        }
        if constexpr (ALIGN_EPI) { if (wr == 0) PG8_BAR; }
        E(acc, cur, wr, wc, fr, fq);
        if (!has_next) break;
#pragma unroll
        for (int a = 0; a < 2; ++a)
#pragma unroll
            for (int b = 0; b < 2; ++b)
#pragma unroll
                for (int m = 0; m < 4; ++m)
#pragma unroll
                    for (int n = 0; n < 2; ++n) acc[a][b][m][n] = (f32x4){0.f, 0.f, 0.f, 0.f};
        cur = nxt; cA = nA; cB = nB; ++ui;
        if constexpr (ALIGN_EPI) { if (wr == 1) PG8_BAR; }
    }
    PG8_WAIT_V(0);
    if constexpr (!ALIGN_EPI) { if (wr == 0) PG8_BAR; }
    PG8_BAR;
#undef PG8_SA
#undef PG8_SB
#undef PG8_STAGE
#undef PG8_LDA
#undef PG8_LDB
#undef PG8_MMA
#undef PG8_WAIT_V
#undef PG8_WAIT_L
#undef PG8_BAR
#undef PG8_SCHED
}
}
using pg8::Unit;
typedef f32x4 AccT[2][2][4][2];

__device__ __forceinline__ void st8(bf16_t* p, f32x4 a, f32x4 b) { u32x4 w; w.x = cvt_pk_bf16(a[0], a[1]); w.y = cvt_pk_bf16(a[2], a[3]); w.z = cvt_pk_bf16(b[0], b[1]); w.w = cvt_pk_bf16(b[2], b[3]); *(u32x4*)p = w; }
__device__ __forceinline__ void st4(bf16_t* p, f32x4 a) { u32x2 w; w.x = cvt_pk_bf16(a[0], a[1]); w.y = cvt_pk_bf16(a[2], a[3]); *(u32x2*)p = w; }
__device__ __forceinline__ f32x4 sig4(f32x4 v) { return (f32x4){sigmoid_f(v[0]), sigmoid_f(v[1]), sigmoid_f(v[2]), sigmoid_f(v[3])}; }

struct EpiSwiGLU {
    static constexpr bool PERM = true;
    bf16_t* H;
    __device__ __forceinline__ void operator()(const AccT& acc, const Unit& u, int wr, int wc, int fr, int fq) const {
        const int row0 = u.pm * 256 + wr * 64 + fr, col0 = u.pn * 128 + wc * 32 + 8 * fq;
#pragma unroll
        for (int ai = 0; ai < 2; ++ai)
#pragma unroll
            for (int m = 0; m < 4; ++m) {
                const f32x4 g0 = acc[ai][0][m][0], g1 = acc[ai][0][m][1], u0 = acc[ai][1][m][0], u1 = acc[ai][1][m][1];
                f32x4 h0, h1;
#pragma unroll
                for (int i = 0; i < 4; ++i) { h0[i] = silu_f(g0[i]) * u0[i]; h1[i] = silu_f(g1[i]) * u1[i]; }
                st8(H + (size_t)(row0 + ai * 128 + m * 16) * FF + col0, h0, h1);
            }
    }
};
struct EpiY {
    static constexpr bool PERM = false;
    float* Y; const bf16_t* E;
    __device__ __forceinline__ void operator()(const AccT& acc, const Unit& u, int wr, int wc, int fr, int fq) const {
        const int row0 = u.pm * 256 + wr * 64 + fr, col0 = u.pn * 256 + wc * 32 + 4 * fq;
#pragma unroll
        for (int ai = 0; ai < 2; ++ai)
#pragma unroll
            for (int m = 0; m < 4; ++m) { const size_t off = (size_t)(row0 + ai * 128 + m * 16) * DM + col0;
#pragma unroll
                for (int bj = 0; bj < 2; ++bj)
#pragma unroll
                    for (int n = 0; n < 2; ++n) { f32x4 v = acc[ai][bj][m][n];
                        if (E) { const u32x2 e = *(const u32x2*)(E + off + bj * 128 + n * 16); v = sig4(v); v[0] *= bflo(e.x); v[1] *= bfhi(e.x); v[2] *= bflo(e.y); v[3] *= bfhi(e.y); }
                        *(f32x4*)(Y + off + bj * 128 + n * 16) = v; } }
    }
};
struct EpiWin {
    static constexpr bool PERM = true;
    unsigned char* ws; const float *ibias, *fbias;
    __device__ __forceinline__ void operator()(const AccT& acc, const Unit& u, int wr, int wc, int fr, int fq) const {
        bf16_t* const CQ = (bf16_t*)(ws + A_CQ); bf16_t* const CKV = (bf16_t*)(ws + A_CKV); bf16_t* const MLQK = (bf16_t*)(ws + A_MLQK); bf16_t* const MLV = (bf16_t*)(ws + A_MLV);
        bf16_t* const MLO = (bf16_t*)(ws + A_MLO); bf16_t* const GATES = (bf16_t*)(ws + A_GATES); bf16_t* const KR = (bf16_t*)(ws + WS_KR);
        float* const LI = (float*)(ws + WS_LI); float* const LF = (float*)(ws + WS_LF); float* const SSQ_Q = (float*)(ws + WS_SSQ_Q); float* const SSQ_KV = (float*)(ws + WS_SSQ_KV);
        const float* const COS = (const float*)(ws + WS_COS); const float* const SIN = (const float*)(ws + WS_SIN);
        const int row0 = u.pm * 256 + wr * 64 + fr, cl = wc * 32 + 8 * fq, pn = u.pn;
        if (pn < 2) {
            bf16_t* dst = pn == 0 ? CQ : CKV; float* ssq = pn == 0 ? SSQ_Q : SSQ_KV;
#pragma unroll
            for (int ai = 0; ai < 2; ++ai)
#pragma unroll
                for (int m = 0; m < 4; ++m) { const int row = row0 + ai * 128 + m * 16; float s = 0.f;
#pragma unroll
                    for (int bj = 0; bj < 2; ++bj) { const f32x4 v0 = acc[ai][bj][m][0], v1 = acc[ai][bj][m][1];
                        s += (v0[0] * v0[0] + v0[1] * v0[1]) + (v0[2] * v0[2] + v0[3] * v0[3]) + (v1[0] * v1[0] + v1[1] * v1[1]) + (v1[2] * v1[2] + v1[3] * v1[3]);
                        st8(dst + (size_t)row * 256 + bj * 128 + cl, v0, v1); }
                    s += __shfl_xor(s, 16); s += __shfl_xor(s, 32);
                    if (fq == 0) unsafeAtomicAdd(ssq + row, s); }
        } else if (pn < 16) {
            bf16_t* dst; int ld, cb; bool sg;
            if (pn < 4) { dst = MLQK; ld = 512; cb = (pn - 2) * 256; sg = false; }
            else if (pn < 6) { dst = MLV; ld = 512; cb = (pn - 4) * 256; sg = false; }
            else if (pn < 8) { dst = MLO; ld = 512; cb = (pn - 6) * 256; sg = true; }
            else { dst = GATES; ld = 2048; cb = (pn - 8) * 256; sg = true; }
#pragma unroll
            for (int ai = 0; ai < 2; ++ai)
#pragma unroll
                for (int m = 0; m < 4; ++m) { const int row = row0 + ai * 128 + m * 16;
#pragma unroll
                    for (int bj = 0; bj < 2; ++bj) { f32x4 v0 = acc[ai][bj][m][0], v1 = acc[ai][bj][m][1];
                        if (sg) { v0 = sig4(v0); v1 = sig4(v1); }
                        st8(dst + (size_t)row * ld + cb + bj * 128 + cl, v0, v1); } }
        } else {
            if (wc == 0) {
#pragma unroll
                for (int ai = 0; ai < 2; ++ai)
#pragma unroll
                    for (int m = 0; m < 4; ++m) { const int row = row0 + ai * 128 + m * 16;
                        const f32x4 x1 = acc[ai][0][m][0], x2 = acc[ai][0][m][1];
                        const f32x4 cs = *(const f32x4*)(COS + (size_t)row * 16 + 4 * fq), sn = *(const f32x4*)(SIN + (size_t)row * 16 + 4 * fq);
                        st4(KR + (size_t)row * 32 + 4 * fq, x1 * cs - x2 * sn); st4(KR + (size_t)row * 32 + 16 + 4 * fq, x2 * cs + x1 * sn); }
            } else if (wc == 1 && fq < 2) {
#pragma unroll
                for (int ai = 0; ai < 2; ++ai)
#pragma unroll
                    for (int m = 0; m < 4; ++m) { const int row = row0 + ai * 128 + m * 16;
                        f32x4 v0 = acc[ai][0][m][0], v1 = acc[ai][0][m][1];
                        if (fq == 0) { v0 += *(const f32x4*)(ibias); v1 += *(const f32x4*)(ibias + 4);
                            *(f32x4*)(LI + (size_t)row * 8) = v0; *(f32x4*)(LI + (size_t)row * 8 + 4) = v1; }
                        else { v0 += *(const f32x4*)(fbias); v1 += *(const f32x4*)(fbias + 4);
#pragma unroll
                            for (int i = 0; i < 4; ++i) { v0[i] = fminf(v0[i], 0.f) - __logf(1.f + __expf(-fabsf(v0[i]))); v1[i] = fminf(v1[i], 0.f) - __logf(1.f + __expf(-fabsf(v1[i]))); }
                            *(f32x4*)(LF + (size_t)row * 8) = v0; *(f32x4*)(LF + (size_t)row * 8 + 4) = v1; } }
            }
        }
    }
};
struct EpiMla {
    static constexpr bool PERM = true;
    unsigned char* ws;
    __device__ __forceinline__ void operator()(const AccT& acc, const Unit& u, int wr, int wc, int fr, int fq) const {
        bf16_t* const Q = (bf16_t*)(ws + A_Q); bf16_t* const KN = (bf16_t*)(ws + A_KN); bf16_t* const V = (bf16_t*)(ws + A_V); bf16_t* const E = (bf16_t*)(ws + A_E);
        const float* const SSQ_Q = (const float*)(ws + WS_SSQ_Q); const float* const SSQ_KV = (const float*)(ws + WS_SSQ_KV);
        const float* const COS = (const float*)(ws + WS_COS); const float* const SIN = (const float*)(ws + WS_SIN);
        const int row0 = u.pm * 256 + wr * 64 + fr, cl = wc * 32 + 8 * fq, pn = u.pn;
        if (pn < 3) {
#pragma unroll
            for (int ai = 0; ai < 2; ++ai)
#pragma unroll
                for (int m = 0; m < 4; ++m) { const int row = row0 + ai * 128 + m * 16;
                    const float rs = __builtin_amdgcn_rsqf(SSQ_Q[row] * (1.0f / 256.0f) + EPS);
#pragma unroll
                    for (int bj = 0; bj < 2; ++bj) { const int G = 8 * pn + 4 * bj + wc; const f32x4 v0 = acc[ai][bj][m][0] * rs, v1 = acc[ai][bj][m][1] * rs;
                        if (G % 3 != 2) st8(Q + (size_t)row * 768 + 32 * G + 8 * fq, v0, v1);
                        else { const f32x4 cs = *(const f32x4*)(COS + (size_t)row * 16 + 4 * fq), sn = *(const f32x4*)(SIN + (size_t)row * 16 + 4 * fq);
                            st4(Q + (size_t)row * 768 + 32 * G + 4 * fq, v0 * cs - v1 * sn); st4(Q + (size_t)row * 768 + 32 * G + 16 + 4 * fq, v1 * cs + v0 * sn); } } }
        } else if (pn < 7) {
            bf16_t* dst = pn < 5 ? KN : V; const int cb = ((pn - 3) & 1) * 256;
#pragma unroll
            for (int ai = 0; ai < 2; ++ai)
#pragma unroll
                for (int m = 0; m < 4; ++m) { const int row = row0 + ai * 128 + m * 16;
                    const float rs = __builtin_amdgcn_rsqf(SSQ_KV[row] * (1.0f / 256.0f) + EPS);
#pragma unroll
                    for (int bj = 0; bj < 2; ++bj) st8(dst + (size_t)row * 512 + cb + bj * 128 + cl, acc[ai][bj][m][0] * rs, acc[ai][bj][m][1] * rs); }
        } else {
            const int cb = (pn - 7) * 256;
#pragma unroll
            for (int ai = 0; ai < 2; ++ai)
#pragma unroll
                for (int m = 0; m < 4; ++m) { const int row = row0 + ai * 128 + m * 16;
#pragma unroll
                    for (int bj = 0; bj < 2; ++bj) st8(E + (size_t)row * DM + cb + bj * 128 + cl, acc[ai][bj][m][0], acc[ai][bj][m][1]); }
        }
    }
};
struct EpiE { static constexpr bool PERM = true; bf16_t* E;
    __device__ __forceinline__ void operator()(const AccT& acc, const Unit& u, int wr, int wc, int fr, int fq) const {
        const int row0 = u.pm * 256 + wr * 64 + fr, cl = u.pn * 256 + wc * 32 + 8 * fq;
#pragma unroll
        for (int ai = 0; ai < 2; ++ai)
#pragma unroll
            for (int m = 0; m < 4; ++m)
#pragma unroll
                for (int bj = 0; bj < 2; ++bj) st8(E + (size_t)(row0 + ai * 128 + m * 16) * DM + bj * 128 + cl, acc[ai][bj][m][0], acc[ai][bj][m][1]); } };
struct EpiBranch {
    static constexpr bool PERM = true;
    bf16_t* MIX; const bf16_t* GATES;
    __device__ __forceinline__ void operator()(const AccT& acc, const Unit& u, int wr, int wc, int fr, int fq) const {
        const int row0 = u.pm * 256 + wr * 64 + fr, col0 = u.pn * 256 + wc * 32 + 8 * fq;
#pragma unroll
        for (int ai = 0; ai < 2; ++ai)
#pragma unroll
            for (int m = 0; m < 4; ++m) { const int row = row0 + ai * 128 + m * 16;
#pragma unroll
                for (int bj = 0; bj < 2; ++bj) { const int col = col0 + bj * 128;
                    const u32x4 g = *(const u32x4*)(GATES + (size_t)row * 2048 + u.kind * 1024 + col);
                    f32x4 v0 = acc[ai][bj][m][0], v1 = acc[ai][bj][m][1];
                    v0[0] *= bflo(g.x); v0[1] *= bfhi(g.x); v0[2] *= bflo(g.y); v0[3] *= bfhi(g.y); v1[0] *= bflo(g.z); v1[1] *= bfhi(g.z); v1[2] *= bflo(g.w); v1[3] *= bfhi(g.w);
                    bf16_t* p = MIX + (size_t)row * DM + col;
                    if (u.kind) { const u32x4 t = *(const u32x4*)p;
                        v0[0] += bflo(t.x); v0[1] += bfhi(t.x); v0[2] += bflo(t.y); v0[3] += bfhi(t.y); v1[0] += bflo(t.z); v1[1] += bfhi(t.z); v1[2] += bflo(t.w); v1[3] += bfhi(t.w); }
                    st8(p, v0, v1); } }
    }
};

struct Ctx { int tid, lane, wave, vcu, G; };
__device__ __forceinline__ Ctx make_ctx() {
    Ctx F; F.tid = threadIdx.x; F.lane = F.tid & 63; F.wave = __builtin_amdgcn_readfirstlane(F.tid >> 6); F.G = gridDim.x;
    const int bx = blockIdx.x; F.vcu = (F.G % 8 == 0) ? (bx % 8) * (F.G / 8) + bx / 8 : bx; return F;
}

enum { MAP_ID = 0, MAP_GATE, MAP_UP, MAP_WIN, MAP_UQ };
__device__ __forceinline__ int map_row(int kind, int n) {
    switch (kind) {
    case MAP_GATE: return ((n >> 7) << 8) + (n & 127);
    case MAP_UP:   return ((n >> 7) << 8) + 128 + (n & 127);
    case MAP_UQ: { const int G = n >> 5, cc = n & 31; if (G % 3 == 2) return 32 * G + 8 * ((cc & 15) >> 2) + 4 * (cc >> 4) + (cc & 3); return n; }
    case MAP_WIN:
        if (n < 512) return n;
        if (n < 544) { const int c = n - 512; return 4096 + 8 * ((c & 15) >> 2) + 4 * (c >> 4) + (c & 3); }
        if (n < 800) return 512 + (n - 544);
        if (n < 1056) return 768 + (n - 800);
        if (n < 1568) return 1024 + (n - 1056);
        if (n < 1576) return 4096 + 32 + (n - 1568);
        if (n < 1584) return 4096 + 40 + (n - 1576);
        if (n < 2096) return 1536 + (n - 1584);
        return 2048 + (n - 2096);
    default: return n;
    }
}
__device__ __forceinline__ void transpose_item(const float* __restrict__ W, int K, int N, bf16_t* WT, int row_off, const float* __restrict__ gain, int mapkind, float* scr, int item, int lane) {
    const int nblk = (N + 31) / 32, kb = item / nblk, nb = item % nblk, k0 = 64 * kb, n0 = 32 * nb;
    const int nn = n0 + (lane & 31);
#pragma unroll 8
    for (int i = 0; i < 32; ++i) { const int kk = 2 * i + (lane >> 5); float v = 0.f; if (nn < N) { v = W[(size_t)(k0 + kk) * N + nn]; if (gain) v *= gain[k0 + kk]; } scr[kk * 33 + (lane & 31)] = v; }
    asm volatile("s_waitcnt lgkmcnt(0)" ::: "memory");
    const int c = lane & 7;
#pragma unroll
    for (int j = 0; j < 4; ++j) { const int nl = (lane >> 3) + 8 * j; const int n = n0 + nl;
        if (n < N) { const float* s = scr + (8 * c) * 33 + nl;
            u32x4 o; o.x = f2bf(s[0]) | (f2bf(s[33]) << 16); o.y = f2bf(s[2 * 33]) | (f2bf(s[3 * 33]) << 16); o.z = f2bf(s[4 * 33]) | (f2bf(s[5 * 33]) << 16); o.w = f2bf(s[6 * 33]) | (f2bf(s[7 * 33]) << 16);
            *(u32x4*)(WT + (size_t)(row_off + map_row(mapkind, n)) * K + k0 + 8 * c) = o; } }
    asm volatile("s_waitcnt lgkmcnt(0)" ::: "memory");
}
struct Ptrs {
    const float* in[33]; float* out; unsigned char* ws;
};
__device__ __forceinline__ void rms_row_to_bf16(const float* xrow, bf16_t* orow, int lane) {
    const f32x4* xr = (const f32x4*)xrow + lane; f32x4 v[4]; float s = 0.f;
#pragma unroll
    for (int j = 0; j < 4; ++j) { v[j] = xr[64 * j]; s += (v[j][0] * v[j][0] + v[j][1] * v[j][1]) + (v[j][2] * v[j][2] + v[j][3] * v[j][3]); }
    const float rstd = 1.0f / sqrtf(wave_sum(s) * (1.0f / DM) + EPS);
    u32x2* o8 = (u32x2*)orow + lane;
#pragma unroll
    for (int j = 0; j < 4; ++j) { u32x2 w; w.x = cvt_pk_bf16(v[j][0] * rstd, v[j][1] * rstd); w.y = cvt_pk_bf16(v[j][2] * rstd, v[j][3] * rstd); o8[64 * j] = w; }
}
__device__ __forceinline__ void phase_prologue(const Ptrs& P, const Ctx& F, unsigned char* lds) {
    float* scr = (float*)(lds + F.wave * 16384);
    const int gw = F.vcu * NWAVES + F.wave, NGW = F.G * NWAVES;
    unsigned char* ws = P.ws;
    int base = 0;
#define TRM(Wp, K_, N_, dst, roff, gainp, mk) do { const int items_ = ((K_) / 64) * (((N_) + 31) / 32); const int first_ = ((gw - base % NGW) + NGW) % NGW; \
        for (int it = first_; it < items_; it += NGW) transpose_item((Wp), (K_), (N_), (bf16_t*)(ws + (dst)), (roff), (gainp), (mk), scr, it, F.lane); base += items_; } while (0)
    TRM(P.in[5], 1024, 2816, W_GU1, 0, P.in[3], MAP_GATE);
    TRM(P.in[6], 1024, 2816, W_GU1, 0, P.in[3], MAP_UP);
    TRM(P.in[7], 2816, 1024, W_D1, 0, nullptr, MAP_ID);
    TRM(P.in[10], 1024, 4144, W_IN, 0, P.in[8], MAP_WIN);
    TRM(P.in[13], 256, 768, W_UQKV, 0, P.in[11], MAP_UQ);
    TRM(P.in[14], 256, 512, W_UQKV, 768, P.in[12], MAP_ID);
    TRM(P.in[15], 256, 512, W_UQKV, 1280, P.in[12], MAP_ID);
    TRM(P.in[31], 256, 1024, W_PLE, 0, nullptr, MAP_ID);
    TRM(P.in[21], 512, 1024, W_A, 0, nullptr, MAP_ID);
    TRM(P.in[22], 512, 1024, W_B, 0, nullptr, MAP_ID);
    TRM(P.in[23], 1024, 1024, W_OUT, 0, nullptr, MAP_ID);
    TRM(P.in[26], 1024, 2816, W_GU2, 0, P.in[24], MAP_GATE);
    TRM(P.in[27], 1024, 2816, W_GU2, 0, P.in[24], MAP_UP);
    TRM(P.in[28], 2816, 1024, W_D2, 0, nullptr, MAP_ID);
    TRM(P.in[32], 1024, 1024, W_PG, 0, P.in[29], MAP_ID);
#undef TRM
    { u32x4* z = (u32x4*)(ws + W_IN + (size_t)(4096 + 48) * 1024 * 2); const int n16 = 208 * 1024 * 2 / 16;
      for (int i = gw * 64 + F.lane; i < n16; i += NGW * 64) z[i] = (u32x4){0u, 0u, 0u, 0u}; }
    for (int m = gw; m < S; m += NGW) rms_row_to_bf16(P.in[0] + (size_t)m * DM, (bf16_t*)(ws + A_XN) + (size_t)m * DM, F.lane);
    { const int* pos = (const int*)P.in[2]; float* C = (float*)(ws + WS_COS); float* Sn = (float*)(ws + WS_SIN);
      for (int i = (gw * 64 + F.lane); i < S * 16; i += NGW * 64) { const int s = i >> 4, j = i & 15;
          const float invf = powf(10000.0f, -(float)(2 * j) / 32.0f); const float ang = (float)pos[s] * invf;
          C[i] = (float)cos((double)ang); Sn[i] = (float)sin((double)ang); } }
}

__device__ __forceinline__ void phase_norm(const float* Y, const float* base, float* out, bf16_t* xn, const float* gain, float alpha, const float* psrc, bf16_t* pb, const Ctx& F) {
    const int gw = F.vcu * NWAVES + F.wave, NGW = F.G * NWAVES, lane = F.lane;
    for (int m = gw; m < S; m += NGW) {
        const f32x4* yr = (const f32x4*)(Y + (size_t)m * DM) + lane; const f32x4* br = (const f32x4*)(base + (size_t)m * DM) + lane; const f32x4* gr = (const f32x4*)gain + lane;
        f32x4 v[4]; float s = 0.f;
#pragma unroll
        for (int j = 0; j < 4; ++j) { v[j] = yr[64 * j]; s += (v[j][0] * v[j][0] + v[j][1] * v[j][1]) + (v[j][2] * v[j][2] + v[j][3] * v[j][3]); }
        const float rstd = alpha / sqrtf(wave_sum(s) * (1.0f / DM) + EPS);
        float s2 = 0.f;
#pragma unroll
        for (int j = 0; j < 4; ++j) { v[j] = br[64 * j] + v[j] * rstd * gr[64 * j]; s2 += (v[j][0] * v[j][0] + v[j][1] * v[j][1]) + (v[j][2] * v[j][2] + v[j][3] * v[j][3]); }
        f32x4* orow = (f32x4*)(out + (size_t)m * DM) + lane;
#pragma unroll
        for (int j = 0; j < 4; ++j) orow[64 * j] = v[j];
        if (xn) { const float r2 = 1.0f / sqrtf(wave_sum(s2) * (1.0f / DM) + EPS); u32x2* o8 = (u32x2*)(xn + (size_t)m * DM) + lane;
#pragma unroll
            for (int j = 0; j < 4; ++j) { u32x2 w; w.x = cvt_pk_bf16(v[j][0] * r2, v[j][1] * r2); w.y = cvt_pk_bf16(v[j][2] * r2, v[j][3] * r2); o8[64 * j] = w; } }
        if (pb) { const f32x4 pv = *((const f32x4*)(psrc + (size_t)m * PLE) + lane); u32x2 w; w.x = cvt_pk_bf16(pv[0], pv[1]); w.y = cvt_pk_bf16(pv[2], pv[3]); *((u32x2*)(pb + (size_t)m * PLE) + lane) = w; }
    }
}

namespace ml {
constexpr int PV = 136;
constexpr int PK = 72;
__device__ __forceinline__ f32x4 mfma16(bf16x8 a, bf16x8 b, f32x4 c) { return __builtin_amdgcn_mfma_f32_16x16x32_bf16(a, b, c, 0, 0, 0); }
__device__ __forceinline__ float scan_add(float v, int lane) {
#pragma unroll
    for (int o = 1; o < 64; o <<= 1) { const float t = __shfl_up(v, o); if (lane >= o) v += t; }
    return v;
}
__device__ __forceinline__ float scan_max(float v, int lane) {
#pragma unroll
    for (int o = 1; o < 64; o <<= 1) { const float t = __shfl_up(v, o); if (lane >= o) v = fmaxf(v, t); }
    return v;
}
__device__ __forceinline__ float rscan_add(float v, int lane) {
#pragma unroll
    for (int o = 1; o < 64; o <<= 1) { const float t = __shfl_down(v, o); if (lane + o < 64) v += t; }
    return v;
}
__device__ __forceinline__ float rscan_max(float v, int lane) {
#pragma unroll
    for (int o = 1; o < 64; o <<= 1) { const float t = __shfl_down(v, o); if (lane + o < 64) v = fmaxf(v, t); }
    return v;
}
__device__ __forceinline__ void conv16(const bf16_t* MLQK, int chan0, int c, int t, const float* cw, const float* cb, int ch0, float (&o)[16]) {
#pragma unroll
    for (int i = 0; i < 16; ++i) o[i] = cb[ch0 + i];
#pragma unroll
    for (int j = 0; j < 5; ++j) { const int srow = c * 128 + t + j - 2;
        if (srow >= 0 && srow < S) { const u32x4* p = (const u32x4*)(MLQK + (size_t)srow * 512 + chan0); const u32x4 a = p[0], b = p[1];
            const float* w = cw + j * 64 + ch0;
            o[0] += w[0] * bflo(a.x); o[1] += w[1] * bfhi(a.x); o[2] += w[2] * bflo(a.y); o[3] += w[3] * bfhi(a.y); o[4] += w[4] * bflo(a.z); o[5] += w[5] * bfhi(a.z); o[6] += w[6] * bflo(a.w); o[7] += w[7] * bfhi(a.w);
            o[8] += w[8] * bflo(b.x); o[9] += w[9] * bfhi(b.x); o[10] += w[10] * bflo(b.y); o[11] += w[11] * bfhi(b.y); o[12] += w[12] * bflo(b.z); o[13] += w[13] * bfhi(b.z); o[14] += w[14] * bflo(b.w); o[15] += w[15] * bfhi(b.w); } }
#pragma unroll
    for (int i = 0; i < 16; ++i) o[i] = silu_f(o[i]);
}
__device__ __forceinline__ void stage_vt(const bf16_t* MLV, int h, int c, bf16_t* VT, int tid) {
    const int s = tid & 127, blk = tid >> 7;
#pragma unroll
    for (int it = 0; it < 4; ++it) { const int dv0 = (blk * 4 + it) * 8;
        const u32x4 x = *(const u32x4*)(MLV + (size_t)(c * 128 + s) * 512 + h * 128 + dv0);
        VT[(dv0 + 0) * PV + s] = (bf16_t)(x.x & 0xffffu); VT[(dv0 + 1) * PV + s] = (bf16_t)(x.x >> 16);
        VT[(dv0 + 2) * PV + s] = (bf16_t)(x.y & 0xffffu); VT[(dv0 + 3) * PV + s] = (bf16_t)(x.y >> 16);
        VT[(dv0 + 4) * PV + s] = (bf16_t)(x.z & 0xffffu); VT[(dv0 + 5) * PV + s] = (bf16_t)(x.z >> 16);
        VT[(dv0 + 6) * PV + s] = (bf16_t)(x.w & 0xffffu); VT[(dv0 + 7) * PV + s] = (bf16_t)(x.w >> 16); }
}
constexpr int A_OFF_VT = 0, A_OFF_KT0 = 128 * PV * 2, A_OFF_KT1 = A_OFF_KT0 + 64 * PV * 2, A_OFF_SC = A_OFF_KT1 + 64 * PV * 2, A_LDS = A_OFF_SC + 8192;
struct MlPtrs { unsigned char* ws; const float *convw, *convb, *hnorm; };
__device__ __forceinline__ void step_a_unit(const MlPtrs& P, int h, int c, unsigned char* lds, const Ctx& F) {
    const bf16_t* const MLQK = (const bf16_t*)(P.ws + A_MLQK); const bf16_t* const MLV = (const bf16_t*)(P.ws + A_MLV); const bf16_t* const MLO = (const bf16_t*)(P.ws + A_MLO);
    const float* const LI = (const float*)(P.ws + WS_LI); const float* const LF = (const float*)(P.ws + WS_LF);
    float* const DC = (float*)(P.ws + A_DC); float* const DN = (float*)(P.ws + WS_DN); float* const MLOC = (float*)(P.ws + WS_MLOC); float* const TOT = (float*)(P.ws + WS_TOT);
    float* const MPREV = (float*)(P.ws + WS_MPREV); float* const NPREV = (float*)(P.ws + WS_NPREV); bf16_t* const CPREV = (bf16_t*)(P.ws + A_CPREV); bf16_t* const BM = (bf16_t*)(P.ws + A_BM);
    (void)MLQK; (void)MLV; (void)MLO; (void)LI; (void)LF; (void)DC; (void)DN; (void)MLOC; (void)TOT; (void)MPREV; (void)NPREV; (void)CPREV; (void)BM;
    const int tid = F.tid, lane = F.lane, wid = F.wave, fr = lane & 15, fq = lane >> 4;
    bf16_t* VT = (bf16_t*)(lds + A_OFF_VT); bf16_t* KT0 = (bf16_t*)(lds + A_OFF_KT0); bf16_t* KT1 = (bf16_t*)(lds + A_OFF_KT1);
    float* sc = (float*)(lds + A_OFF_SC); float* lf0 = sc, *lf1 = sc + 128, *li0 = sc + 256, *li1 = sc + 384, *w0 = sc + 512, *w1 = sc + 640, *cw = sc + 768, *cb = sc + 1088;
    if (tid < 128) { const size_t s = (size_t)c * 128 + tid; lf0[tid] = LF[s * 8 + h]; lf1[tid] = LF[s * 8 + 4 + h]; li0[tid] = LI[s * 8 + h]; li1[tid] = LI[s * 8 + 4 + h]; }
    else if (tid < 448) { const int i = tid - 128, j = i >> 6, ch = i & 63; cw[i] = P.convw[j * 512 + 256 + h * 64 + ch]; }
    else { const int ch = tid - 448; cb[ch] = P.convb[256 + h * 64 + ch]; }
    __syncthreads();
    if (wid == 0) {
        const float x0 = lf0[2 * lane], x1 = lf0[2 * lane + 1]; const float Pi = scan_add(x0 + x1, lane); const float tot = __shfl(Pi, 63);
        const float g0 = tot - (Pi - x1) + li0[2 * lane], g1 = tot - Pi + li0[2 * lane + 1];
        const float mx = wave_max(fmaxf(g0, g1));
        w0[2 * lane] = __expf(g0 - mx); w0[2 * lane + 1] = __expf(g1 - mx);
        if (lane == 0) { MLOC[(0 * 4 + h) * 128 + c] = mx; TOT[(0 * 4 + h) * 128 + c] = tot; }
    } else if (wid == 1) {
        const float x0 = lf1[2 * lane], x1 = lf1[2 * lane + 1]; const float Pi = scan_add(x0 + x1, lane); const float tot = __shfl(Pi, 63);
        const float g0 = (Pi - x0 - x1) + li1[2 * lane], g1 = (Pi - x1) + li1[2 * lane + 1];
        const float mx = wave_max(fmaxf(g0, g1));
        w1[2 * lane] = __expf(g0 - mx); w1[2 * lane + 1] = __expf(g1 - mx);
        if (lane == 0) { MLOC[(1 * 4 + h) * 128 + c] = mx; TOT[(1 * 4 + h) * 128 + c] = tot; }
    }
    __syncthreads();
    { const int t = tid >> 2, ch0 = (tid & 3) * 16; float kv[16];
      conv16(MLQK, 256 + h * 64 + ch0, c, t, cw, cb, ch0, kv);
      const float a0 = w0[t] * 0.125f, a1 = w1[t] * 0.125f;
#pragma unroll
      for (int i = 0; i < 16; ++i) { KT0[(ch0 + i) * PV + t] = (bf16_t)f2bf(kv[i] * a0); KT1[(ch0 + i) * PV + t] = (bf16_t)f2bf(kv[i] * a1); } }
    stage_vt(MLV, h, c, VT, tid);
    __syncthreads();
#pragma unroll
    for (int d = 0; d < 2; ++d) {
        const bf16_t* KT = d ? KT1 : KT0; f32x4 acc[4];
#pragma unroll
        for (int n = 0; n < 4; ++n) acc[n] = (f32x4){0.f, 0.f, 0.f, 0.f};
#pragma unroll
        for (int ks = 0; ks < 4; ++ks) { const bf16x8 a = *(const bf16x8*)(VT + (16 * wid + fr) * PV + 32 * ks + 8 * fq);
#pragma unroll
            for (int n = 0; n < 4; ++n) { const bf16x8 b = *(const bf16x8*)(KT + (16 * n + fr) * PV + 32 * ks + 8 * fq); acc[n] = mfma16(a, b, acc[n]); } }
        float* dc = DC + ((size_t)((d * 4 + h) * 128 + c)) * 8192;
#pragma unroll
        for (int n = 0; n < 4; ++n)
#pragma unroll
            for (int r = 0; r < 4; ++r) dc[(16 * wid + 4 * fq + r) * 64 + 16 * n + fr] = acc[n][r];
    }
    { const int d = wid >> 2, n = wid & 3; const bf16_t* KT = d ? KT1 : KT0; f32x4 acc = (f32x4){0.f, 0.f, 0.f, 0.f};
      const bf16x8 ones = (bf16x8){0x3F80, 0x3F80, 0x3F80, 0x3F80, 0x3F80, 0x3F80, 0x3F80, 0x3F80};
#pragma unroll
      for (int ks = 0; ks < 4; ++ks) { const bf16x8 b = *(const bf16x8*)(KT + (16 * n + fr) * PV + 32 * ks + 8 * fq); acc = mfma16(ones, b, acc); }
      if (fq == 0) DN[((size_t)((d * 4 + h) * 128 + c)) * 64 + 16 * n + fr] = acc[0]; }
    __syncthreads();
}
__device__ __forceinline__ void step_b(const MlPtrs& P, const Ctx& F) {
    const bf16_t* const MLQK = (const bf16_t*)(P.ws + A_MLQK); const bf16_t* const MLV = (const bf16_t*)(P.ws + A_MLV); const bf16_t* const MLO = (const bf16_t*)(P.ws + A_MLO);
    const float* const LI = (const float*)(P.ws + WS_LI); const float* const LF = (const float*)(P.ws + WS_LF);
    float* const DC = (float*)(P.ws + A_DC); float* const DN = (float*)(P.ws + WS_DN); float* const MLOC = (float*)(P.ws + WS_MLOC); float* const TOT = (float*)(P.ws + WS_TOT);
    float* const MPREV = (float*)(P.ws + WS_MPREV); float* const NPREV = (float*)(P.ws + WS_NPREV); bf16_t* const CPREV = (bf16_t*)(P.ws + A_CPREV); bf16_t* const BM = (bf16_t*)(P.ws + A_BM);
    (void)MLQK; (void)MLV; (void)MLO; (void)LI; (void)LF; (void)DC; (void)DN; (void)MLOC; (void)TOT; (void)MPREV; (void)NPREV; (void)CPREV; (void)BM;
    const int gid = F.vcu * NTHREADS + F.tid;
    if (gid >= 65536 + 512) return;
    const bool isn = gid >= 65536; const int dh = isn ? ((gid - 65536) >> 6) : (gid >> 13), e = isn ? ((gid - 65536) & 63) : (gid & 8191), d = dh >> 2;
    const size_t esz = isn ? 64 : 8192;
    const float* src = (isn ? DN : DC) + (size_t)dh * 128 * esz + e;
    float st = 0.f, m = 0.f;
#pragma unroll 4
    for (int j = 0; j < 128; ++j) { const int c = d ? 127 - j : j;
        const float dv = src[(size_t)c * esz]; const float ml = MLOC[dh * 128 + c], tt = TOT[dh * 128 + c];
        if (isn) NPREV[((size_t)dh * 128 + c) * 64 + e] = st; else CPREV[((size_t)dh * 128 + c) * 8192 + e] = (bf16_t)f2bf(st);
        if (!isn && e == 0) MPREV[dh * 128 + c] = m;
        const float mn = fmaxf(tt + m, ml);
        st = __expf(tt + m - mn) * st + __expf(ml - mn) * dv; m = mn; }
}
constexpr int C_OFF_QS = 0, C_OFF_KS = 128 * PK * 2, C_OFF_QI = 2 * 128 * PK * 2, C_OFF_CT = 3 * 128 * PK * 2, C_OFF_VT = 4 * 128 * PK * 2, C_OFF_P = C_OFF_VT + 128 * PV * 2, C_OFF_SC = C_OFF_P + 128 * PV * 2, C_LDS = C_OFF_SC + 10240;
__device__ __forceinline__ void step_c_unit(const MlPtrs& P, int h, int c, unsigned char* lds, const Ctx& F) {
    const bf16_t* const MLQK = (const bf16_t*)(P.ws + A_MLQK); const bf16_t* const MLV = (const bf16_t*)(P.ws + A_MLV); const bf16_t* const MLO = (const bf16_t*)(P.ws + A_MLO);
    const float* const LI = (const float*)(P.ws + WS_LI); const float* const LF = (const float*)(P.ws + WS_LF);
    float* const DC = (float*)(P.ws + A_DC); float* const DN = (float*)(P.ws + WS_DN); float* const MLOC = (float*)(P.ws + WS_MLOC); float* const TOT = (float*)(P.ws + WS_TOT);
    float* const MPREV = (float*)(P.ws + WS_MPREV); float* const NPREV = (float*)(P.ws + WS_NPREV); bf16_t* const CPREV = (bf16_t*)(P.ws + A_CPREV); bf16_t* const BM = (bf16_t*)(P.ws + A_BM);
    (void)MLQK; (void)MLV; (void)MLO; (void)LI; (void)LF; (void)DC; (void)DN; (void)MLOC; (void)TOT; (void)MPREV; (void)NPREV; (void)CPREV; (void)BM;
    const int tid = F.tid, lane = F.lane, wid = F.wave, fr = lane & 15, fq = lane >> 4;
    bf16_t* Qs = (bf16_t*)(lds + C_OFF_QS); bf16_t* Ks = (bf16_t*)(lds + C_OFF_KS); bf16_t* QI = (bf16_t*)(lds + C_OFF_QI); bf16_t* CT0 = (bf16_t*)(lds + C_OFF_CT);
    bf16_t* CT1 = Ks; bf16_t* VT = (bf16_t*)(lds + C_OFF_VT); bf16_t* Pm = (bf16_t*)(lds + C_OFF_P);
    float* sc = (float*)(lds + C_OFF_SC);
    float* lf = sc;
    float* li = sc + 256;
    float* av = sc + 512;
    float* mu = sc + 768;
    float* it_ = sc + 1024;
    float* em = sc + 1280;
    float* np = sc + 1536;
    float* cwq = sc + 1664;
    float* cwk = sc + 1984;
    float* cbq = sc + 2304;
    float* cbk = sc + 2368;
    if (tid < 128) { const size_t s = (size_t)c * 128 + tid; lf[tid] = LF[s * 8 + h]; lf[128 + tid] = LF[s * 8 + 4 + h]; li[tid] = LI[s * 8 + h]; li[128 + tid] = LI[s * 8 + 4 + h]; }
    else if (tid < 256) { const int i = tid - 128, d = i >> 6, e = i & 63; np[i] = NPREV[((size_t)((d * 4 + h) * 128 + c)) * 64 + e]; }
    for (int i = tid; i < 320; i += NTHREADS) { const int j = i >> 6, ch = i & 63; cwq[i] = P.convw[j * 512 + h * 64 + ch]; cwk[i] = P.convw[j * 512 + 256 + h * 64 + ch]; }
    if (tid >= 320 && tid < 384) { const int ch = tid - 320; cbq[ch] = P.convb[h * 64 + ch]; cbk[ch] = P.convb[256 + h * 64 + ch]; }
    __syncthreads();
    if (wid == 0) {
        const float mp = MPREV[(0 * 4 + h) * 128 + c];
        const float x0 = lf[2 * lane], x1 = lf[2 * lane + 1]; const float Pi = scan_add(x0 + x1, lane);
        const float b0 = Pi - x1, b1 = Pi; const float a0 = li[2 * lane] - b0, a1 = li[2 * lane + 1] - b1;
        const float pm = scan_max(fmaxf(a0, a1), lane); float ex = __shfl_up(pm, 1); if (lane == 0) ex = -INFINITY;
        const float M0 = fmaxf(ex, a0), M1 = pm; const float u0 = fmaxf(mp, M0), u1 = fmaxf(mp, M1);
        av[2 * lane] = a0; av[2 * lane + 1] = a1; mu[2 * lane] = u0; mu[2 * lane + 1] = u1;
        it_[2 * lane] = __expf(mp - u0); it_[2 * lane + 1] = __expf(mp - u1); em[2 * lane] = __expf(-(b0 + u0)); em[2 * lane + 1] = __expf(-(b1 + u1));
    } else if (wid == 1) {
        const float mp = MPREV[(1 * 4 + h) * 128 + c];
        const float x0 = lf[128 + 2 * lane], x1 = lf[128 + 2 * lane + 1]; const float Ps = rscan_add(x0 + x1, lane);
        const float b0 = Ps, b1 = Ps - x0; const float a0 = li[128 + 2 * lane] - b0, a1 = li[128 + 2 * lane + 1] - b1;
        const float sm = rscan_max(fmaxf(a0, a1), lane); float ex = __shfl_down(sm, 1); if (lane == 63) ex = -INFINITY;
        const float M0 = sm, M1 = fmaxf(ex, a1); const float u0 = fmaxf(mp, M0), u1 = fmaxf(mp, M1);
        av[128 + 2 * lane] = a0; av[128 + 2 * lane + 1] = a1; mu[128 + 2 * lane] = u0; mu[128 + 2 * lane + 1] = u1;
        it_[128 + 2 * lane] = __expf(mp - u0); it_[128 + 2 * lane + 1] = __expf(mp - u1); em[128 + 2 * lane] = __expf(-(b0 + u0)); em[128 + 2 * lane + 1] = __expf(-(b1 + u1));
    }
    { const int t = tid >> 2, ch0 = (tid & 3) * 16; float qv[16], kv[16];
      conv16(MLQK, h * 64 + ch0, c, t, cwq, cbq, ch0, qv);
      conv16(MLQK, 256 + h * 64 + ch0, c, t, cwk, cbk, ch0, kv);
      u32x4 a, b;
      a.x = cvt_pk_bf16(qv[0], qv[1]); a.y = cvt_pk_bf16(qv[2], qv[3]); a.z = cvt_pk_bf16(qv[4], qv[5]); a.w = cvt_pk_bf16(qv[6], qv[7]);
      b.x = cvt_pk_bf16(qv[8], qv[9]); b.y = cvt_pk_bf16(qv[10], qv[11]); b.z = cvt_pk_bf16(qv[12], qv[13]); b.w = cvt_pk_bf16(qv[14], qv[15]);
      *(u32x4*)(Qs + t * PK + ch0) = a; *(u32x4*)(Qs + t * PK + ch0 + 8) = b;
#pragma unroll
      for (int i = 0; i < 16; ++i) kv[i] *= 0.125f;
      a.x = cvt_pk_bf16(kv[0], kv[1]); a.y = cvt_pk_bf16(kv[2], kv[3]); a.z = cvt_pk_bf16(kv[4], kv[5]); a.w = cvt_pk_bf16(kv[6], kv[7]);
      b.x = cvt_pk_bf16(kv[8], kv[9]); b.y = cvt_pk_bf16(kv[10], kv[11]); b.z = cvt_pk_bf16(kv[12], kv[13]); b.w = cvt_pk_bf16(kv[14], kv[15]);
      *(u32x4*)(Ks + t * PK + ch0) = a; *(u32x4*)(Ks + t * PK + ch0 + 8) = b; }
    stage_vt(MLV, h, c, VT, tid);
    {
      const bf16_t* src = CPREV + ((size_t)((0 * 4 + h) * 128 + c)) * 8192;
#pragma unroll
      for (int i = 0; i < 2; ++i) { const int idx = tid + i * NTHREADS, r = idx >> 3, ch = idx & 7; *(u32x4*)(CT0 + r * PK + ch * 8) = *(const u32x4*)(src + r * 64 + ch * 8); } }
    __syncthreads();
    f32x4 sacc[8];
    { const bf16x8 q0 = *(const bf16x8*)(Qs + (16 * wid + fr) * PK + 8 * fq), q1 = *(const bf16x8*)(Qs + (16 * wid + fr) * PK + 32 + 8 * fq);
#pragma unroll
      for (int st = 0; st < 8; ++st) { sacc[st] = (f32x4){0.f, 0.f, 0.f, 0.f};
          const bf16x8 k0 = *(const bf16x8*)(Ks + (16 * st + fr) * PK + 8 * fq), k1 = *(const bf16x8*)(Ks + (16 * st + fr) * PK + 32 + 8 * fq);
          sacc[st] = mfma16(k0, q0, sacc[st]); sacc[st] = mfma16(k1, q1, sacc[st]); } }
    __syncthreads();
    { const bf16_t* src = CPREV + ((size_t)((1 * 4 + h) * 128 + c)) * 8192;
#pragma unroll
      for (int i = 0; i < 2; ++i) { const int idx = tid + i * NTHREADS, r = idx >> 3, ch = idx & 7; *(u32x4*)(CT1 + r * PK + ch * 8) = *(const u32x4*)(src + r * 64 + ch * 8); } }
    __syncthreads();
    const int tl = 16 * wid + fr;
    f32x4 hs[8];
#pragma unroll
    for (int d = 0; d < 2; ++d) {
        const float mut = mu[d * 128 + tl], inter = it_[d * 128 + tl], emt = em[d * 128 + tl];
        float rs = 0.f;
#pragma unroll
        for (int st = 0; st < 8; ++st) { const f32x4 a4 = *(const f32x4*)(av + d * 128 + 16 * st + 4 * fq); f32x4 sv;
#pragma unroll
            for (int r = 0; r < 4; ++r) { const int sp = 16 * st + 4 * fq + r; const bool ok = d ? (sp >= tl) : (sp <= tl);
                const float w = ok ? __expf(a4[r] - mut) : 0.f; sv[r] = sacc[st][r] * w; rs += sv[r]; }
            st4(Pm + tl * PV + 16 * st + 4 * fq, sv); }
        rs += __shfl_xor(rs, 16); rs += __shfl_xor(rs, 32);
        float qn = 0.f;
        { const u32x4 a = *(const u32x4*)(Qs + tl * PK + 16 * fq), b = *(const u32x4*)(Qs + tl * PK + 16 * fq + 8); const float* n_ = np + d * 64 + 16 * fq;
          float q[16] = {bflo(a.x), bfhi(a.x), bflo(a.y), bfhi(a.y), bflo(a.z), bfhi(a.z), bflo(a.w), bfhi(a.w), bflo(b.x), bfhi(b.x), bflo(b.y), bfhi(b.y), bflo(b.z), bfhi(b.z), bflo(b.w), bfhi(b.w)};
#pragma unroll
          for (int i = 0; i < 16; ++i) { qn += q[i] * n_[i]; q[i] *= inter; }
          u32x4 oa, ob;
          oa.x = cvt_pk_bf16(q[0], q[1]); oa.y = cvt_pk_bf16(q[2], q[3]); oa.z = cvt_pk_bf16(q[4], q[5]); oa.w = cvt_pk_bf16(q[6], q[7]);
          ob.x = cvt_pk_bf16(q[8], q[9]); ob.y = cvt_pk_bf16(q[10], q[11]); ob.z = cvt_pk_bf16(q[12], q[13]); ob.w = cvt_pk_bf16(q[14], q[15]);
          *(u32x4*)(QI + tl * PK + 16 * fq) = oa; *(u32x4*)(QI + tl * PK + 16 * fq + 8) = ob; }
        qn += __shfl_xor(qn, 16); qn += __shfl_xor(qn, 32);
        const float den = rs + inter * qn;
        const float rden = 1.0f / fmaxf(fabsf(den), emt);
        __syncthreads();
        const bf16_t* CT = d ? CT1 : CT0;
        bf16x8 pb[4], qb[2];
#pragma unroll
        for (int ks = 0; ks < 4; ++ks) pb[ks] = *(const bf16x8*)(Pm + tl * PV + 32 * ks + 8 * fq);
        qb[0] = *(const bf16x8*)(QI + tl * PK + 8 * fq); qb[1] = *(const bf16x8*)(QI + tl * PK + 32 + 8 * fq);
#pragma unroll
        for (int dvt = 0; dvt < 8; ++dvt) { f32x4 na = (f32x4){0.f, 0.f, 0.f, 0.f};
#pragma unroll
            for (int ks = 0; ks < 4; ++ks) { const bf16x8 a = *(const bf16x8*)(VT + (16 * dvt + fr) * PV + 32 * ks + 8 * fq); na = mfma16(a, pb[ks], na); }
#pragma unroll
            for (int ks = 0; ks < 2; ++ks) { const bf16x8 a = *(const bf16x8*)(CT + (16 * dvt + fr) * PK + 32 * ks + 8 * fq); na = mfma16(a, qb[ks], na); }
            if (d == 0) hs[dvt] = na * rden; else hs[dvt] += na * rden; }
        __syncthreads();
    }
    float ss = 0.f;
#pragma unroll
    for (int dvt = 0; dvt < 8; ++dvt) ss += (hs[dvt][0] * hs[dvt][0] + hs[dvt][1] * hs[dvt][1]) + (hs[dvt][2] * hs[dvt][2] + hs[dvt][3] * hs[dvt][3]);
    ss += __shfl_xor(ss, 16); ss += __shfl_xor(ss, 32);
    const float rstd = 1.0f / sqrtf(ss * (1.0f / 128.0f) + EPS);
    const size_t srow = (size_t)c * 128 + tl;
#pragma unroll
    for (int dvt = 0; dvt < 8; ++dvt) { const int col = h * 128 + 16 * dvt + 4 * fq;
        const f32x4 g = *(const f32x4*)(P.hnorm + col); const u32x2 o = *(const u32x2*)(MLO + srow * 512 + col);
        f32x4 v = hs[dvt] * rstd * g; v[0] *= bflo(o.x); v[1] *= bfhi(o.x); v[2] *= bflo(o.y); v[3] *= bfhi(o.y);
        st4(BM + srow * 512 + col, v); }
    __syncthreads();
}
}

namespace att {
constexpr int NW = 8, QBLK = 32, KVBLK = 64;
constexpr float SCALE = 0.10206207261596575f;
constexpr float THR = 8.f;
constexpr int SHM_V = KVBLK * 64 * 2, SHM_K = KVBLK * 256, SHM_ATTN = 2 * SHM_V + 2 * SHM_K + NW * 64 * 4;
#define KSWZ(row, colB) ((row) * 256 + ((colB) ^ (((row) & 7) << 4)))
#define SBAR() __builtin_amdgcn_sched_barrier(0)
__device__ __forceinline__ int crow(int r, int hi) { return (r & 3) + 8 * (r >> 2) + 4 * hi; }
__device__ __forceinline__ void partialSM(f32x16& p0, f32x16& p1, float& m_reg, float& mn, float& alpha) {
    constexpr float C = SCALE * 1.4426950408889634f;
    float pmax = p0[0];
#pragma unroll
    for (int r = 1; r < 16; ++r) pmax = fmaxf(pmax, p0[r]);
#pragma unroll
    for (int r = 0; r < 16; ++r) pmax = fmaxf(pmax, p1[r]);
    { auto rr = __builtin_amdgcn_permlane32_swap(__float_as_uint(pmax), __float_as_uint(pmax), false, false);
      pmax = fmaxf(__uint_as_float(rr[0]), __uint_as_float(rr[1])); }
    if (__builtin_expect(__all(pmax - m_reg <= THR / SCALE), 1)) { mn = m_reg; alpha = 1.f; }
    else { mn = fmaxf(m_reg, pmax); alpha = __builtin_amdgcn_exp2f((m_reg - mn) * C); m_reg = mn; }
    const float mnC = -mn * C;
#pragma unroll
    for (int r = 0; r < 16; ++r) p0[r] = fmaf(p0[r], C, mnC);
#pragma unroll
    for (int r = 0; r < 16; ++r) p1[r] = fmaf(p1[r], C, mnC);
#pragma unroll
    for (int r = 0; r < 16; ++r) p0[r] = __builtin_amdgcn_exp2f(p0[r]);
}
__device__ __forceinline__ void finishSM(f32x16& p0, f32x16& p1, float alpha, float& l_reg, bf16x8& pa0, bf16x8& pa1, bf16x8& pa2, bf16x8& pa3) {
#pragma unroll
    for (int r = 0; r < 16; ++r) p1[r] = __builtin_amdgcn_exp2f(p1[r]);
    float ps = 0;
#pragma unroll
    for (int r = 0; r < 16; ++r) ps += p0[r];
#pragma unroll
    for (int r = 0; r < 16; ++r) ps += p1[r];
    { auto rr = __builtin_amdgcn_permlane32_swap(__float_as_uint(ps), __float_as_uint(ps), false, false);
      ps = __uint_as_float(rr[0]) + __uint_as_float(rr[1]); }
    l_reg = l_reg * alpha + ps;
#define PK4(P, BASE, OUT) do { unsigned a0 = cvt_pk_bf16(P[BASE + 0], P[BASE + 1]), a1 = cvt_pk_bf16(P[BASE + 2], P[BASE + 3]);   \
    unsigned b0 = cvt_pk_bf16(P[BASE + 4], P[BASE + 5]), b1 = cvt_pk_bf16(P[BASE + 6], P[BASE + 7]);                              \
    auto r0 = __builtin_amdgcn_permlane32_swap(a0, b0, false, false); auto r1 = __builtin_amdgcn_permlane32_swap(a1, b1, false, false); \
    u32x4 w = {r0[0], r1[0], r0[1], r1[1]}; OUT = *reinterpret_cast<bf16x8*>(&w); } while (0)
    PK4(p0, 0, pa0); PK4(p0, 8, pa1); PK4(p1, 0, pa2); PK4(p1, 8, pa3);
#undef PK4
}
__device__ __forceinline__ void qkt(f32x16& p0, f32x16& p1, const char* Ks, const bf16x8* qr, int r32, int hi) {
    p0 = f32x16{}; p1 = f32x16{};
#pragma unroll
    for (int d0 = 0; d0 < 6; ++d0) { const int cb = (d0 * 16 + hi * 8) * 2;
        const bf16x8 b0 = *reinterpret_cast<const bf16x8*>(Ks + KSWZ(r32, cb));
        const bf16x8 b1 = *reinterpret_cast<const bf16x8*>(Ks + KSWZ(32 + r32, cb));
        p0 = __builtin_amdgcn_mfma_f32_32x32x16_bf16(b0, qr[d0], p0, 0, 0, 0);
        p1 = __builtin_amdgcn_mfma_f32_32x32x16_bf16(b1, qr[d0], p1, 0, 0, 0); }
}
__device__ __forceinline__ int v_st(int k, int c) { const int kk = (k & ~0xC) | ((k & 4) << 1) | ((k & 8) >> 1); return ((kk >> 3) * 2 + (c >> 5)) * 512 + ((kk & 7) * 32 + (c & 31)) * 2; }
__device__ __forceinline__ int v_rd_base(int lane) { return ((lane & 3) << 3) | (((lane >> 2) & 3) << 6) | (((lane >> 4) & 1) << 5) | (((lane >> 5) & 1) << 8); }
constexpr int v_rd_off(int d0, int ks, int half) { return d0 * 512 + ks * 2048 + half * 1024; }
template <int OFF> __device__ __forceinline__ s16x4 tr_read(int vb) {
    s16x4 r; asm volatile("ds_read_b64_tr_b16 %0, %1 offset:%2" : "=&v"(r) : "v"(vb), "i"(OFF) : "memory"); return r;
}
template <int D0> __device__ __forceinline__ void pv_one(f32x16& od, int vb, bf16x8 pa0, bf16x8 pa1, bf16x8 pa2, bf16x8 pa3) {
    const s16x4 l0 = tr_read<v_rd_off(D0, 0, 0)>(vb), h0 = tr_read<v_rd_off(D0, 0, 1)>(vb), l1 = tr_read<v_rd_off(D0, 1, 0)>(vb), h1 = tr_read<v_rd_off(D0, 1, 1)>(vb);
    const s16x4 l2 = tr_read<v_rd_off(D0, 2, 0)>(vb), h2 = tr_read<v_rd_off(D0, 2, 1)>(vb), l3 = tr_read<v_rd_off(D0, 3, 0)>(vb), h3 = tr_read<v_rd_off(D0, 3, 1)>(vb);
    asm volatile("s_waitcnt lgkmcnt(0)" ::: "memory"); SBAR();
#define PKV(L, H) (bf16x8){L[0], L[1], L[2], L[3], H[0], H[1], H[2], H[3]}
    od = __builtin_amdgcn_mfma_f32_32x32x16_bf16(pa0, PKV(l0, h0), od, 0, 0, 0);
    od = __builtin_amdgcn_mfma_f32_32x32x16_bf16(pa1, PKV(l1, h1), od, 0, 0, 0);
    od = __builtin_amdgcn_mfma_f32_32x32x16_bf16(pa2, PKV(l2, h2), od, 0, 0, 0);
    od = __builtin_amdgcn_mfma_f32_32x32x16_bf16(pa3, PKV(l3, h3), od, 0, 0, 0);
#undef PKV
}
__device__ __forceinline__ void pv_d0(f32x16* o, int vb, bf16x8 pa0, bf16x8 pa1, bf16x8 pa2, bf16x8 pa3) {
    pv_one<0>(o[0], vb, pa0, pa1, pa2, pa3); pv_one<1>(o[1], vb, pa0, pa1, pa2, pa3);
}
__device__ __forceinline__ void attn_unit(const bf16_t* __restrict__ Q, const bf16_t* __restrict__ KN, const bf16_t* __restrict__ KR, const bf16_t* __restrict__ V, bf16_t* __restrict__ O, int h, int q0, char* lds) {
    const int tid = threadIdx.x, wid = tid >> 6, lane = tid & 63, r32 = lane & 31, hi = lane >> 5;
    char* V_lds = lds; char* K_lds = lds + 2 * SHM_V;
    float* ws = (float*)(lds + 2 * SHM_V + 2 * SHM_K) + wid * 64; float* li_l = ws; float* al_l = ws + 32;
    float m_reg = -1e30f, l_reg = 0; f32x16 o[2] = {}; bf16x8 qr[6];
    const bf16_t* Qw = Q + (size_t)(q0 + wid * QBLK + r32) * 768 + h * 96 + hi * 8;
#pragma unroll
    for (int d0 = 0; d0 < 6; ++d0) qr[d0] = *reinterpret_cast<const bf16x8*>(Qw + d0 * 16);
    const int vr = tid >> 3, vc = (tid & 7) * 8, vst = v_st(vr, vc);
    const int c0 = tid, c1 = 512 + (tid & 255);
    const int kr0 = c0 / 12, kc0 = c0 % 12, kr1 = c1 / 12, kc1 = c1 % 12;
    const bf16_t* ksrc0 = kc0 < 8 ? KN + (size_t)kr0 * 512 + h * 64 + kc0 * 8 : KR + (size_t)kr0 * 32 + (kc0 - 8) * 8; const size_t kstr0 = kc0 < 8 ? 512 : 32;
    const bf16_t* ksrc1 = kc1 < 8 ? KN + (size_t)kr1 * 512 + h * 64 + kc1 * 8 : KR + (size_t)kr1 * 32 + (kc1 - 8) * 8; const size_t kstr1 = kc1 < 8 ? 512 : 32;
    const int kst0 = KSWZ(kr0, kc0 * 16), kst1 = KSWZ(kr1, kc1 * 16);
    const bf16_t* vsrc = V + (size_t)vr * 512 + h * 64 + vc;
    const int vb0 = (int)(uintptr_t)V_lds + v_rd_base(lane);
    struct { bf16x8 vs, ks0, ks1; } sr_[2];
#define SLOAD(i, k0) do { sr_[i].vs = *reinterpret_cast<const bf16x8*>(vsrc + (size_t)(k0) * 512); \
    sr_[i].ks0 = *reinterpret_cast<const bf16x8*>(ksrc0 + (size_t)(k0) * kstr0); sr_[i].ks1 = *reinterpret_cast<const bf16x8*>(ksrc1 + (size_t)(k0) * kstr1); } while (0)
#define SWRITE(b, i) do { *(bf16x8*)(V_lds + (b) * SHM_V + vst) = sr_[i].vs; *(bf16x8*)(K_lds + (b) * SHM_K + kst0) = sr_[i].ks0; *(bf16x8*)(K_lds + (b) * SHM_K + kst1) = sr_[i].ks1; } while (0)
#define SWAIT() asm volatile("s_waitcnt vmcnt(3)" ::: "memory")
#define RESC(a) do { if (__any((a) < 1.f)) { if (hi == 0) al_l[r32] = (a); asm volatile("s_waitcnt lgkmcnt(0)" ::: "memory"); \
    _Pragma("unroll") for (int d = 0; d < 2; ++d) _Pragma("unroll") for (int r = 0; r < 16; ++r) o[d][r] *= al_l[crow(r, hi)]; } } while (0)
    f32x16 pA0, pA1, pB0, pB1; float mnA, mnB, alA, alB; bf16x8 pa0, pa1, pa2, pa3; const int NT = S / KVBLK;
    constexpr int SE = 0, SO = 1;
    SLOAD(SE, 0); asm volatile("s_waitcnt vmcnt(0)" ::: "memory"); SWRITE(0, SE); __syncthreads();
    qkt(pA0, pA1, K_lds, qr, r32, hi); partialSM(pA0, pA1, m_reg, mnA, alA);
    SLOAD(SO, KVBLK); SLOAD(SE, 2 * KVBLK);
    SWAIT(); SWRITE(1, SO); __syncthreads();
    for (int j = 1; j + 1 < NT; j += 2) {
        SBAR(); qkt(pB0, pB1, K_lds + SHM_K, qr, r32, hi);
        finishSM(pA0, pA1, alA, l_reg, pa0, pa1, pa2, pa3); SBAR();
        SLOAD(SO, (j + 2) * KVBLK); SBAR();
        pv_d0(o, vb0, pa0, pa1, pa2, pa3); partialSM(pB0, pB1, m_reg, mnB, alB);
        __syncthreads(); SWAIT(); SWRITE(0, SE);
        RESC(alB); __syncthreads();
        SBAR(); qkt(pA0, pA1, K_lds, qr, r32, hi);
        finishSM(pB0, pB1, alB, l_reg, pa0, pa1, pa2, pa3); SBAR();
        if (j + 3 < NT) SLOAD(SE, (j + 3) * KVBLK); SBAR();
        pv_d0(o, vb0 + SHM_V, pa0, pa1, pa2, pa3); partialSM(pA0, pA1, m_reg, mnA, alA);
        __syncthreads(); SWAIT(); SWRITE(1, SO);
        RESC(alA); __syncthreads();
    }
    SBAR(); qkt(pB0, pB1, K_lds + SHM_K, qr, r32, hi);
    finishSM(pA0, pA1, alA, l_reg, pa0, pa1, pa2, pa3); SBAR();
    pv_d0(o, vb0, pa0, pa1, pa2, pa3); partialSM(pB0, pB1, m_reg, mnB, alB);
    __syncthreads(); RESC(alB);
    finishSM(pB0, pB1, alB, l_reg, pa0, pa1, pa2, pa3); SBAR();
    pv_d0(o, vb0 + SHM_V, pa0, pa1, pa2, pa3);
    if (hi == 0) li_l[r32] = l_reg; asm volatile("s_waitcnt lgkmcnt(0)" ::: "memory");
    float rli[16];
#pragma unroll
    for (int r = 0; r < 16; ++r) rli[r] = __builtin_amdgcn_rcpf(li_l[crow(r, hi)]);
    bf16_t* Ow = O + (size_t)(q0 + wid * QBLK) * 512 + h * 64;
#pragma unroll
    for (int r = 0; r < 16; ++r) { const int orow = crow(r, hi);
#pragma unroll
        for (int d0 = 0; d0 < 2; ++d0) Ow[(size_t)orow * 512 + d0 * 32 + r32] = (bf16_t)f2bf(o[d0][r] * rli[r]); }
    __syncthreads();
#undef SLOAD
#undef SWRITE
#undef SWAIT
#undef RESC
}
}

constexpr int LDS_GEMM = pg8::STAGE_BYTES;
constexpr int LDS_MAX = 155648;
static_assert(ml::C_LDS <= LDS_MAX && ml::A_LDS <= LDS_MAX && att::SHM_ATTN <= LDS_MAX && LDS_GEMM <= LDS_MAX, "LDS map");

struct Args { Ptrs p; int phase; int pad; };

template <int PH> __global__ void __launch_bounds__(NTHREADS, 2) k_phase(Args a) {
    extern __shared__ __attribute__((aligned(16))) unsigned char lds[];
    const Ctx F = make_ctx();
    const Ptrs& P = a.p; unsigned char* ws = P.ws;
    LAS unsigned char* l3 = (LAS unsigned char*)lds;
    const ml::MlPtrs MP{ws, P.in[16], P.in[17], P.in[20]};
    switch (PH) {
    case 0: phase_prologue(P, F, lds); break;
    case 1: case 13: {
        typedef pg8::SchedGrid<22, 22, 22, A_XN, A_XN, A_XN, (PH == 1 ? W_GU1 : W_GU2), 1024> SG; const SG Sg{F.G, (int)blockIdx.x, (const char*)ws};
        EpiSwiGLU E{(bf16_t*)(ws + A_HID)};
        pg8::gemm_phase<EpiSwiGLU, SG, true>(l3, 1024, Sg, E); break; }
    case 2: case 14: {
        typedef pg8::SchedGrid<4, 4, 4, A_HID, A_HID, A_HID, (PH == 2 ? W_D1 : W_D2), 2816> SG; const SG Sg{F.G, (int)blockIdx.x, (const char*)ws};
        EpiY E{(float*)(ws + A_Y), nullptr};
        pg8::gemm_phase<EpiY, SG, true>(l3, 2816, Sg, E); break; }
    case 3: phase_norm((const float*)(ws + A_Y), P.in[0], P.out, (bf16_t*)(ws + A_XN), P.in[4], 0.5f, nullptr, nullptr, F); break;
    case 4: {
        typedef pg8::SchedGrid<17, 17, 17, A_XN, A_XN, A_XN, W_IN, 1024> SG; const SG Sg{F.G, (int)blockIdx.x, (const char*)ws};
        EpiWin E{ws, P.in[18], P.in[19]};
        pg8::gemm_phase<EpiWin, SG, true>(l3, 1024, Sg, E); break; }
    case 5: for (int u = F.vcu; u < 512; u += F.G) ml::step_a_unit(MP, u >> 7, u & 127, lds, F); break;
    case 6: ml::step_b(MP, F); break;
    case 7: for (int u = F.vcu; u < 512; u += F.G) ml::step_c_unit(MP, u >> 7, u & 127, lds, F); break;
    case 8: {
        typedef pg8::SchedGrid<7, 3, 7, A_CQ, A_CKV, A_CKV, W_UQKV, 256> SG; const SG Sg{F.G, (int)blockIdx.x, (const char*)ws};
        EpiMla E{ws};
        pg8::gemm_phase<EpiMla, SG, true>(l3, 256, Sg, E); break; }
    case 9: for (int u = 2 * F.vcu; u < 2 * F.vcu + 2 && u < 512; ++u)
                att::attn_unit((const bf16_t*)(ws + A_Q), (const bf16_t*)(ws + A_KN), (const bf16_t*)(ws + WS_KR), (const bf16_t*)(ws + A_V), (bf16_t*)(ws + A_O), u >> 6, (u & 63) * 256, (char*)lds);
            break;
    case 10: {
        typedef pg8::SchedPair<4, A_O, A_BM, W_A, W_B, 512> SP; const SP Sp{F.G, (int)blockIdx.x, (const char*)ws};
        EpiBranch E{(bf16_t*)(ws + A_MIX), (const bf16_t*)(ws + A_GATES)};
        pg8::gemm_phase<EpiBranch, SP, true>(l3, 512, Sp, E); break; }
    case 11: {
        typedef pg8::SchedGrid<4, 4, 4, A_MIX, A_MIX, A_MIX, W_OUT, 1024> SG; const SG Sg{F.G, (int)blockIdx.x, (const char*)ws};
        EpiY E{(float*)(ws + A_Y2), nullptr};
        pg8::gemm_phase<EpiY, SG, true>(l3, 1024, Sg, E); break; }
    case 12: phase_norm((const float*)(ws + A_Y2), P.out, P.out, (bf16_t*)(ws + A_XN), P.in[9], 1.0f, nullptr, nullptr, F); break;
    case 15: phase_norm((const float*)(ws + A_Y), P.out, P.out, (bf16_t*)(ws + A_XN), P.in[25], 0.5f, P.in[1], (bf16_t*)(ws + A_PB), F); break;
    case 16: {
        typedef pg8::SchedGrid<4, 4, 4, A_PB, A_PB, A_PB, W_PLE, 256> SG; const SG Sg{F.G, (int)blockIdx.x, (const char*)ws};
        EpiE E2{(bf16_t*)(ws + A_E)};
        pg8::gemm_phase<EpiE, SG, true>(l3, 256, Sg, E2); break; }
    case 17: {
        typedef pg8::SchedGrid<4, 4, 4, A_XN, A_XN, A_XN, W_PG, 1024> SG; const SG Sg{F.G, (int)blockIdx.x, (const char*)ws};
        EpiY E{(float*)(ws + A_Y), (const bf16_t*)(ws + A_E)};
        pg8::gemm_phase<EpiY, SG, true>(l3, 1024, Sg, E); break; }
    case 18: phase_norm((const float*)(ws + A_Y), P.out, P.out, nullptr, P.in[30], 1.0f, nullptr, nullptr, F); break;
    default: break;
    }
}

extern "C" void kernel_launch(void* const* d_in, const int* in_sizes, int n_in, void* d_out, int out_size, void* d_ws, size_t ws_size, hipStream_t stream) {
    static int ok = 0;
    if (ok == 0) {
        if (n_in != 33 || out_size != S * DM || ws_size < WS_END) { fprintf(stderr, "kernel_launch: unexpected shapes n_in %d out %d ws %zu\n", n_in, out_size, ws_size); ok = -1; return; }
#define SETA(ph) if (hipFuncSetAttribute((const void*)k_phase<ph>, hipFuncAttributeMaxDynamicSharedMemorySize, LDS_MAX) != hipSuccess) { fprintf(stderr, "kernel_launch: hipFuncSetAttribute failed\n"); ok = -1; return; }
        SETA(0) SETA(1) SETA(2) SETA(3) SETA(4) SETA(5) SETA(6) SETA(7) SETA(8) SETA(9) SETA(10) SETA(11) SETA(12) SETA(13) SETA(14) SETA(15) SETA(16) SETA(17) SETA(18)
#undef SETA
        ok = 1;
    }
    if (ok < 0) return;
    (void)hipMemsetAsync((char*)d_ws + WS_CTL, 0, CTL_ZERO_BYTES, stream);
    Args a{};
    for (int i = 0; i < 33; ++i) a.p.in[i] = (const float*)d_in[i];
    a.p.out = (float*)d_out; a.p.ws = (unsigned char*)d_ws;
#define LAUNCH(ph) do { a.phase = ph; hipLaunchKernelGGL(k_phase<ph>, dim3(256), dim3(NTHREADS), LDS_MAX, stream, a); } while (0)
    LAUNCH(0); LAUNCH(1); LAUNCH(2); LAUNCH(3); LAUNCH(4); LAUNCH(5); LAUNCH(6); LAUNCH(7); LAUNCH(8); LAUNCH(9);
    LAUNCH(10); LAUNCH(11); LAUNCH(12); LAUNCH(13); LAUNCH(14); LAUNCH(15); LAUNCH(16); LAUNCH(17); LAUNCH(18);
#undef LAUNCH
}
```
